# Optimizing an MI355X kernel written in HIP

```python
import math
import jax, jax.numpy as jnp
from jax import lax
import numpy as np

D_MODEL = 1024
BATCH = 16
SEQ = 2048
DEPTH = 4

N_MEM = 256
EPS = 1e-6
D_FF = 2816
SSD_HEADS = 16
SSD_HEAD_DIM = 64
SSD_INNER = SSD_HEADS * SSD_HEAD_DIM
SSD_GROUPS = 2
SSD_HPG = SSD_HEADS // SSD_GROUPS
SSD_STATE = 128
SSD_CONV = 5
SSD_CHUNK = 128
SSD_CONV_CH = SSD_INNER + 2 * SSD_GROUPS * SSD_STATE
MLA_HEADS = 8
MLA_Q_RANK = 512
MLA_KV_RANK = 256
MLA_NOPE = 64
MLA_ROPE = 32
MLA_V = 64
MLA_Q_BLOCK = 128
ROPE_THETA = 10000.0
IN_SPLITS = (
    SSD_INNER,
    SSD_INNER + SSD_CONV_CH,
    SSD_INNER + SSD_CONV_CH + 2 * SSD_HEADS,
    SSD_INNER + SSD_CONV_CH + 2 * SSD_HEADS + MLA_Q_RANK,
    SSD_INNER + SSD_CONV_CH + 2 * SSD_HEADS + MLA_Q_RANK + MLA_KV_RANK,
)
IN_COLS = IN_SPLITS[-1] + MLA_ROPE
MIX_WIDTH = SSD_INNER + MLA_HEADS * MLA_V
FNET_GROUPS = 4
FNET_GROUP_CH = D_MODEL // FNET_GROUPS
XA_HEADS = 4
XA_HEAD_DIM = D_MODEL // XA_HEADS
N_EVEN = (DEPTH + 1) // 2
N_ODD = DEPTH // 2

kernel_name = "hybrid_ssd_mla_fnet_macaron_encoder"


def rmsnorm(x, w):
    xf = x.astype(jnp.float32)
    y = xf * lax.rsqrt(jnp.mean(xf * xf, axis=-1, keepdims=True) + EPS)
    return (y * w.astype(jnp.float32)).astype(x.dtype)


def swiglu_ffn(x, w_gu, w_down):
    g, u = jnp.split(x @ w_gu, 2, axis=-1)
    return (jax.nn.silu(g) * u) @ w_down


def rope_tables(positions):
    inv = 1.0 / (ROPE_THETA ** (jnp.arange(0, MLA_ROPE, 2, dtype=jnp.float32) / MLA_ROPE))
    ang = positions.astype(jnp.float32)[..., None] * inv
    return jnp.cos(ang), jnp.sin(ang)


def apply_rope(x, cos, sin):
    x1, x2 = jnp.split(x.astype(jnp.float32), 2, axis=-1)
    return jnp.concatenate([x1 * cos - x2 * sin, x1 * sin + x2 * cos], axis=-1).astype(x.dtype)


def centred_depthwise_conv(x, w, bias):
    ch = x.shape[-1]
    y = lax.conv_general_dilated(
        x, w[:, None, :].astype(x.dtype), window_strides=(1,),
        padding=[(SSD_CONV // 2, SSD_CONV // 2)],
        dimension_numbers=("NWC", "WIO", "NWC"), feature_group_count=ch)
    return y + bias.astype(x.dtype)


def ssd_chunked(xdt, la, bm, cm):
    b, l, g, r, p = xdt.shape
    n = bm.shape[-1]
    q = SSD_CHUNK
    nc = l // q
    xdt = xdt.reshape(b, nc, q, g, r, p)
    la = la.reshape(b, nc, q, g, r)
    bm = bm.reshape(b, nc, q, g, n)
    cm = cm.reshape(b, nc, q, g, n)
    cum = jnp.cumsum(la, axis=2)
    lower = jnp.tril(jnp.ones((q, q), dtype=bool))[:, :, None, None]
    seg = cum[:, :, :, None] - cum[:, :, None, :]
    decay = jnp.exp(jnp.where(lower, seg, -jnp.inf))
    cb = jnp.einsum("bzlgn,bzsgn->bzlsg", cm, bm)
    y_diag = jnp.einsum("bzlsgr,bzsgrp->bzlgrp", cb[..., None] * decay, xdt)
    decay_end = jnp.exp(cum[:, :, -1:] - cum)
    states = jnp.einsum("bzsgn,bzsgrp->bzgrpn", bm, xdt * decay_end[..., None])
    chunk_decay = jnp.exp(cum[:, :, -1])

    def carry_step(h, inp):
        s_z, d_z = inp
        return h * d_z[..., None, None] + s_z, h

    h0 = jnp.zeros((b, g, r, p, n), xdt.dtype)
    _, h_in = lax.scan(carry_step, h0, (jnp.moveaxis(states, 1, 0), jnp.moveaxis(chunk_decay, 1, 0)))
    h_in = jnp.moveaxis(h_in, 0, 1)
    y_off = jnp.einsum("bzlgn,bzgrpn->bzlgrp", cm, h_in) * jnp.exp(cum)[..., None]
    return (y_diag + y_off).reshape(b, l, g, r, p)


def block_attention(q, k, v, scale):
    b, s, h, dk = q.shape
    nb = s // MLA_Q_BLOCK
    qb = jnp.moveaxis(q.reshape(b, nb, MLA_Q_BLOCK, h, dk), 1, 0)

    def one_block(qi):
        sc = jnp.einsum("bqhd,bkhd->bhqk", qi, k).astype(jnp.float32) * scale
        pr = jax.nn.softmax(sc, axis=-1).astype(v.dtype)
        return jnp.einsum("bhqk,bkhd->bqhd", pr, v)

    o = lax.map(one_block, qb)
    return jnp.moveaxis(o, 0, 1).reshape(b, s, h, v.shape[-1])


def ssd_mla_mixer(u, cos, sin, w_in, conv_w, conv_b, dt_bias, a_log, ssd_d, ssd_norm,
                  q_norm, w_uq, kv_norm, w_ukv, w_out):
    b, s, _ = u.shape
    z, xbc, dt_raw, c_q, c_kv, k_rope = jnp.split(u @ w_in, IN_SPLITS, axis=-1)
    xbc = jax.nn.silu(centred_depthwise_conv(xbc, conv_w, conv_b))
    xs, bm, cm = jnp.split(xbc, [SSD_INNER, SSD_INNER + SSD_GROUPS * SSD_STATE], axis=-1)
    xs = xs.astype(jnp.float32).reshape(b, s, SSD_GROUPS, SSD_HPG, SSD_HEAD_DIM)
    bm = bm.astype(jnp.float32).reshape(b, s, SSD_GROUPS, SSD_STATE)
    cm = cm.astype(jnp.float32).reshape(b, s, SSD_GROUPS, SSD_STATE)
    dt = jax.nn.softplus(dt_raw.astype(jnp.float32).reshape(b, s, 2, SSD_GROUPS, SSD_HPG)
                         + dt_bias.astype(jnp.float32).reshape(2, SSD_GROUPS, SSD_HPG))
    a = -jnp.exp(a_log.astype(jnp.float32)).reshape(2, SSD_GROUPS, SSD_HPG)
    y_fwd = ssd_chunked(xs * dt[:, :, 0, ..., None], dt[:, :, 0] * a[0], bm, cm)
    flip = lambda t: jnp.flip(t, axis=1)
    y_bwd = flip(ssd_chunked(flip(xs * dt[:, :, 1, ..., None]), flip(dt[:, :, 1] * a[1]), flip(bm), flip(cm)))
    y = y_fwd + y_bwd + xs * ssd_d.astype(jnp.float32).reshape(SSD_GROUPS, SSD_HPG, 1)
    y = y.reshape(b, s, SSD_INNER).astype(u.dtype)
    y_ssd = rmsnorm(y * jax.nn.silu(z), ssd_norm)
    q = (rmsnorm(c_q, q_norm) @ w_uq).reshape(b, s, MLA_HEADS, MLA_NOPE + MLA_ROPE)
    q_nope, q_pe = jnp.split(q, [MLA_NOPE], axis=-1)
    q_pe = apply_rope(q_pe, cos[:, :, None], sin[:, :, None])
    kv = (rmsnorm(c_kv, kv_norm) @ w_ukv).reshape(b, s, MLA_HEADS, MLA_NOPE + MLA_V)
    k_nope, v = jnp.split(kv, [MLA_NOPE], axis=-1)
    k_pe = apply_rope(k_rope, cos, sin)
    k = jnp.concatenate([k_nope, jnp.broadcast_to(k_pe[:, :, None], (b, s, MLA_HEADS, MLA_ROPE))], axis=-1)
    qf = jnp.concatenate([q_nope, q_pe], axis=-1)
    o_mla = block_attention(qf, k, v, (MLA_NOPE + MLA_ROPE) ** -0.5).reshape(b, s, MLA_HEADS * MLA_V)
    return jnp.concatenate([y_ssd, o_mla], axis=-1) @ w_out


def fourier_mixer(u, w_out):
    b, s, d = u.shape
    ug = jnp.moveaxis(u.astype(jnp.float32).reshape(b, s, FNET_GROUPS, FNET_GROUP_CH), 2, 1)
    f = jnp.fft.fft2(ug, norm="ortho").real
    return jnp.moveaxis(f, 1, 2).reshape(b, s, d).astype(u.dtype) @ w_out


def memory_cross_attention(hn, mem_n, wq, wkv, wo):
    b, s, d = hn.shape
    t = mem_n.shape[1]
    q = (hn @ wq).reshape(b, s, XA_HEADS, XA_HEAD_DIM)
    k, v = jnp.split(mem_n @ wkv, 2, axis=-1)
    k = k.reshape(b, t, XA_HEADS, XA_HEAD_DIM)
    v = v.reshape(b, t, XA_HEADS, XA_HEAD_DIM)
    sc = jnp.einsum("bqhd,bkhd->bhqk", q, k).astype(jnp.float32) * (XA_HEAD_DIM ** -0.5)
    pr = jax.nn.softmax(sc, axis=-1).astype(v.dtype)
    o = jnp.einsum("bhqk,bkhd->bqhd", pr, v).reshape(b, s, d)
    return o @ wo


def setup_inputs(seed: int = 0) -> dict:
    key = jax.random.key(seed)
    ks = iter(jax.random.split(key, 32))
    f32 = jnp.float32

    def nrm(shape, fan_in):
        return jax.random.normal(next(ks), shape, f32) * (fan_in ** -0.5)

    def gain(shape):
        return 1.0 + 0.02 * jax.random.normal(next(ks), shape, f32)

    L, E, O = DEPTH, N_EVEN, N_ODD
    x = jax.random.normal(next(ks), (BATCH, SEQ, D_MODEL), f32)
    mem = jax.random.normal(next(ks), (BATCH, N_MEM, D_MODEL), f32)
    positions = jnp.broadcast_to(jnp.arange(SEQ, dtype=jnp.int32)[None], (BATCH, SEQ))
    mem_norm = gain((D_MODEL,))
    final_norm = gain((D_MODEL,))
    ffn1_norm = gain((L, D_MODEL))
    ffn1_w_gu = nrm((L, D_MODEL, 2 * D_FF), D_MODEL)
    ffn1_w_down = nrm((L, D_FF, D_MODEL), D_FF)
    mix_norm = gain((L, D_MODEL))
    xa_norm = gain((L, D_MODEL))
    xa_wq = nrm((L, D_MODEL, D_MODEL), D_MODEL)
    xa_wkv = nrm((L, D_MODEL, 2 * D_MODEL), D_MODEL)
    xa_wo = nrm((L, D_MODEL, D_MODEL), D_MODEL)
    ffn2_norm = gain((L, D_MODEL))
    ffn2_w_gu = nrm((L, D_MODEL, 2 * D_FF), D_MODEL)
    ffn2_w_down = nrm((L, D_FF, D_MODEL), D_FF)
    w_in = nrm((E, D_MODEL, IN_COLS), D_MODEL)
    conv_w = nrm((E, SSD_CONV, SSD_CONV_CH), SSD_CONV)
    conv_b = 0.02 * jax.random.normal(next(ks), (E, SSD_CONV_CH), f32)
    dt0 = jnp.exp(jax.random.uniform(next(ks), (E, 2, SSD_HEADS), f32,
                                     minval=math.log(1e-3), maxval=math.log(1e-1)))
    dt_bias = dt0 + jnp.log(-jnp.expm1(-dt0))
    a_log = jnp.log(jax.random.uniform(next(ks), (E, 2, SSD_HEADS), f32, minval=1.0, maxval=16.0))
    ssd_d = 1.0 + 0.1 * jax.random.normal(next(ks), (E, SSD_HEADS), f32)
    ssd_norm = gain((E, SSD_INNER))
    q_norm = gain((E, MLA_Q_RANK))
    w_uq = nrm((E, MLA_Q_RANK, MLA_HEADS * (MLA_NOPE + MLA_ROPE)), MLA_Q_RANK)
    kv_norm = gain((E, MLA_KV_RANK))
    w_ukv = nrm((E, MLA_KV_RANK, MLA_HEADS * (MLA_NOPE + MLA_V)), MLA_KV_RANK)
    w_out = nrm((E, MIX_WIDTH, D_MODEL), MIX_WIDTH)
    fnet_w_out = nrm((O, D_MODEL, D_MODEL), D_MODEL)
    return {
        "x": x, "mem": mem, "positions": positions, "mem_norm": mem_norm, "final_norm": final_norm,
        "ffn1_norm": ffn1_norm, "ffn1_w_gu": ffn1_w_gu, "ffn1_w_down": ffn1_w_down,
        "mix_norm": mix_norm, "xa_norm": xa_norm, "xa_wq": xa_wq, "xa_wkv": xa_wkv, "xa_wo": xa_wo,
        "ffn2_norm": ffn2_norm, "ffn2_w_gu": ffn2_w_gu, "ffn2_w_down": ffn2_w_down,
        "w_in": w_in, "conv_w": conv_w, "conv_b": conv_b, "dt_bias": dt_bias, "a_log": a_log,
        "ssd_d": ssd_d, "ssd_norm": ssd_norm, "q_norm": q_norm, "w_uq": w_uq, "kv_norm": kv_norm,
        "w_ukv": w_ukv, "w_out": w_out, "fnet_w_out": fnet_w_out,
    }


def reference(x, mem, positions, mem_norm, final_norm,
              ffn1_norm, ffn1_w_gu, ffn1_w_down,
              mix_norm, xa_norm, xa_wq, xa_wkv, xa_wo,
              ffn2_norm, ffn2_w_gu, ffn2_w_down,
              w_in, conv_w, conv_b, dt_bias, a_log, ssd_d, ssd_norm,
              q_norm, w_uq, kv_norm, w_ukv, w_out, fnet_w_out):
    cos, sin = rope_tables(positions)
    mem_n = rmsnorm(mem, mem_norm)
    h = x
    for layer in range(DEPTH):
        h = h + 0.5 * swiglu_ffn(rmsnorm(h, ffn1_norm[layer]), ffn1_w_gu[layer], ffn1_w_down[layer])
        u = rmsnorm(h, mix_norm[layer])
        if layer % 2 == 0:
            e = layer // 2
            h = h + ssd_mla_mixer(u, cos, sin, w_in[e], conv_w[e], conv_b[e], dt_bias[e], a_log[e],
                                  ssd_d[e], ssd_norm[e], q_norm[e], w_uq[e], kv_norm[e], w_ukv[e], w_out[e])
        else:
            h = h + fourier_mixer(u, fnet_w_out[layer // 2])
        h = h + memory_cross_attention(rmsnorm(h, xa_norm[layer]), mem_n, xa_wq[layer], xa_wkv[layer], xa_wo[layer])
        h = h + 0.5 * swiglu_ffn(rmsnorm(h, ffn2_norm[layer]), ffn2_w_gu[layer], ffn2_w_down[layer])
    return rmsnorm(h, final_norm)
```

```cpp
#include <hip/hip_runtime.h>
#include <hip/hip_cooperative_groups.h>
#include <cstdio>
namespace cg = cooperative_groups;

#define LAS __attribute__((address_space(3)))
typedef unsigned short bf16_t;
typedef short bf16x8 __attribute__((ext_vector_type(8)));
typedef short bf16x4 __attribute__((ext_vector_type(4)));
typedef float f32x4 __attribute__((ext_vector_type(4)));
typedef unsigned u32x2 __attribute__((ext_vector_type(2)));
typedef unsigned u32x4 __attribute__((ext_vector_type(4)));

constexpr int T_TOK = 32768, DM = 1024, SEQ = 2048, NB = 16, DFF = 2816, NMEM = 256, TMEM = 4096;
constexpr float LOG2E = 1.4426950408889634f;
constexpr float EPS = 1e-6f;

constexpr size_t W_GU1 = 0, W_DN1 = 5767168, W_GU2 = 8650752, W_DN2 = 14417920, W_Q = 17301504, W_K = 18350080, W_V = 19398656, W_O = 20447232, W_MIX = 21495808;
constexpr size_t W_IN = W_MIX, W_UQ = W_IN + 3670016, W_KN = W_UQ + 393216, W_VV = W_KN + 131072, W_OY = W_VV + 131072, W_OO = W_OY + 1048576;
constexpr size_t W_FT = W_MIX, W_FOLD = W_FT + 1048576;
constexpr size_t WB_ELEMS = 27394048;
constexpr size_t OFF_WB = 0;
constexpr size_t OFF_FSEQ = OFF_WB + WB_ELEMS * 2;
constexpr size_t OFF_TCH = OFF_FSEQ + 8388608;
constexpr size_t OFF_HB = OFF_TCH + 262144;
constexpr size_t OFF_MEMB = OFF_HB + 67108864;
constexpr size_t OFF_KMEM = OFF_MEMB + 8388608;
constexpr size_t OFF_VTM = OFF_KMEM + 8388608;
constexpr size_t OFF_ROWSS = OFF_VTM + 8388608;
constexpr size_t RS_H0 = 0, RS_H1 = (size_t)T_TOK * 16, RS_CQ = (size_t)T_TOK * 32, RS_CKV = (size_t)T_TOK * 48, RS_G = (size_t)T_TOK * 64, RS_TOTAL = (size_t)T_TOK * 80;
constexpr size_t OFF_MEMSS = OFF_ROWSS + RS_TOTAL * 4;
constexpr size_t OFF_SCR = OFF_MEMSS + 4096 * 16 * 4;
constexpr size_t S_ACT = 0;
constexpr size_t S_XQ = 0, S_XO = 67108864;
constexpr size_t S_UT = 0, S_YCS = 67108864;
constexpr size_t S_Z = 0, S_XBC = 100663296, S_QB = S_XBC, S_KN = S_XBC + 50331648, S_CQ = 201326592, S_CKV = 234881024, S_DTRAW = 251658240,
                 S_KROPE = 255852544, S_XT = 257949696, S_BCC = 325058560, S_CUM = 358612992, S_END = 367001600;
constexpr size_t OFF_BAR = OFF_SCR + S_END;
constexpr size_t WS_NEED = OFF_BAR + 16384;
constexpr size_t CUM_ARR = (size_t)T_TOK * 16;

struct Args { const void* in[29]; float* out; unsigned char* ws; int ph_lo, ph_hi; };

__device__ __forceinline__ unsigned cvt_pk_bf16(float lo, float hi) { unsigned r; asm volatile("v_cvt_pk_bf16_f32 %0, %1, %2" : "=v"(r) : "v"(lo), "v"(hi)); return r; }
__device__ __forceinline__ float bf2f(unsigned short b) { return __uint_as_float(((unsigned)b) << 16); }
__device__ __forceinline__ float bflo(unsigned u) { return __uint_as_float(u << 16); }
__device__ __forceinline__ float bfhi(unsigned u) { return __uint_as_float(u & 0xffff0000u); }
__device__ __forceinline__ float fexp2(float x) { return __builtin_amdgcn_exp2f(x); }
__device__ __forceinline__ float frcp(float x) { return __builtin_amdgcn_rcpf(x); }
__device__ __forceinline__ float silu_f(float g) { return g * frcp(1.0f + fexp2(-g * LOG2E)); }
__device__ __forceinline__ float rstd_of(float ss, float inv_dim) { return rsqrtf(ss * inv_dim + EPS); }
__device__ __forceinline__ float shfl_xor_f(float v, int m) { return __shfl_xor(v, m, 64); }
__device__ __forceinline__ float ss_sum(const float* p, size_t row, int) {
    const f32x4* q = (const f32x4*)(p + row * 16); const f32x4 a = q[0], b = q[1], c = q[2], d = q[3];
    const f32x4 t = (a + b) + (c + d); return (t[0] + t[1]) + (t[2] + t[3]); }

__device__ __forceinline__ int opaque_tid() { int t = threadIdx.x; asm volatile("" : "+v"(t)); return t; }

__device__ __forceinline__ int xcd_item(int trip, int n_items) {
    const int x = blockIdx.x & 7, s = blockIdx.x >> 3, per = n_items >> 3, nslot = gridDim.x >> 3;
    const int local = trip * nslot + s; return local < per ? x * per + local : -1;
}

constexpr int BM = 256, BK = 64, HALF = 128, HTB = HALF * BK * 2, STAGE_BYTES = 8 * HTB, NXCD = 8, WGM = 8;
constexpr int LDS_XST = STAGE_BYTES, LDS_RSC = STAGE_BYTES + 256, LDS_BYTES = LDS_RSC + 512 * 36;
__device__ __forceinline__ int lds_byte(int r, int c) { const int st = (r >> 4) * 2 + (c >> 5), rr = r & 15, cc = c & 31, ob = rr * 64 + cc * 2; return st * 1024 + (ob ^ (((ob >> 9) & 1) << 5)); }
__device__ __forceinline__ void stage_rc(int b, int& R, int& C) { const int st = b / 1024, sb = b % 1024, swz = sb ^ (((sb >> 9) & 1) << 5); R = (st >> 1) * 16 + swz / 64; C = (st & 1) * 32 + (swz % 64) / 2; }

__device__ __forceinline__ int perm32(int rho) { const int n = rho >> 4, i = rho & 15; return 8 * (i >> 2) + 4 * n + (i & 3); }
struct Unit { int pm, pn, pz; };
struct Gemm { const bf16_t* A; const bf16_t* Bt; int lda, ldb, K, nM, nN, nZ, zd, rot; long sA1, sA2, sB1, sB2; };
__device__ __forceinline__ Gemm mk_gemm(const bf16_t* A, int lda, const bf16_t* Bt, int ldb, int K, int nM, int nN) {
    Gemm g; g.A = A; g.Bt = Bt; g.lda = lda; g.ldb = ldb; g.K = K; g.nM = nM; g.nN = nN; g.nZ = 1; g.zd = 1; g.rot = 0; g.sA1 = g.sA2 = g.sB1 = g.sB2 = 0; return g; }

__device__ __forceinline__ bool next_unit(const Gemm& g, int i, Unit& u) {
    const int nwg = g.nM * g.nN;
    const long L = (long)i * gridDim.x + (int)((blockIdx.x + gridDim.x - (unsigned)g.rot) % gridDim.x); if (L >= (long)nwg * g.nZ) return false;
    u.pz = (int)(L / nwg); int wgid = (int)(L % nwg);
    { const int q = nwg / NXCD, r = nwg % NXCD, xcd = wgid % NXCD, off = wgid / NXCD; wgid = (xcd < r ? xcd * (q + 1) : r * (q + 1) + (xcd - r) * q) + off; }
    const int nig = WGM * g.nN, gid = wgid / nig, fm = gid * WGM, gsz = (g.nM - fm) < WGM ? (g.nM - fm) : WGM;
    u.pm = fm + ((wgid % nig) % gsz); u.pn = (wgid % nig) / gsz; return true;
}
__device__ __forceinline__ const char* unit_A(const Gemm& g, const Unit& u) { return (const char*)(g.A + (size_t)(u.pz / g.zd) * g.sA1 + (size_t)(u.pz % g.zd) * g.sA2 + (size_t)u.pm * BM * g.lda); }
__device__ __forceinline__ const char* unit_B(const Gemm& g, const Unit& u) { return (const char*)(g.Bt + (size_t)(u.pz / g.zd) * g.sB1 + (size_t)(u.pz % g.zd) * g.sB2 + (size_t)u.pn * BM * g.ldb); }

template <class Epi>
__device__ __forceinline__ void gemm_phase(LAS unsigned char* lds, const Gemm g, const Epi& E) {
    int tid_ = threadIdx.x; asm volatile("" : "+v"(tid_));
    const int tid = tid_, wid = __builtin_amdgcn_readfirstlane(tid >> 6), lane = tid & 63, wr = wid >> 2, wc = wid & 3, fr = lane & 15, fq = lane >> 4;
    const int K = g.K, nt = K / BK;
    unsigned voffA[2], voffB[2];
#pragma unroll
    for (int i = 0; i < 2; ++i) { int R, C; stage_rc(tid * 16 + i * 8192, R, C);
        const int Rb = Epi::PERM ? ((R & ~31) + perm32(R & 31)) : R;
        voffA[i] = (unsigned)(R * g.lda + C) * 2u; voffB[i] = (unsigned)(Rb * g.ldb + C) * 2u; }
    const size_t kstep = (size_t)(BK * 2);
    const size_t hstepA = (size_t)HALF * g.lda * 2, hstepB = (size_t)HALF * g.ldb * 2;
    const unsigned ldsw = (unsigned)wid * 1024u;
    const int aoff = lds_byte(wr * 64 + fr, fq * 8), boff = lds_byte(wc * 32 + fr, fq * 8);
#define PG8_SA(b, h) (((b) * 2 + (h)) * HTB)
#define PG8_SB(b, h) ((4 + (b) * 2 + (h)) * HTB)
#define PG8_STAGE(bufoff, gbase, voff) do { _Pragma("unroll") for (int _i = 0; _i < 2; ++_i) \
        __builtin_amdgcn_global_load_lds((const unsigned*)((const char*)(gbase) + (voff)[_i]), (LAS unsigned*)(lds + (bufoff) + ldsw + _i * 8192), 16, 0, 0); } while (0)
#define PG8_LDA(dst, b, h) do { _Pragma("unroll") for (int m = 0; m < 4; ++m) _Pragma("unroll") for (int k = 0; k < 2; ++k) dst[m][k] = *(const LAS bf16x8*)(lds + PG8_SA(b, h) + aoff + m * 2048 + k * 1024); } while (0)
#define PG8_LDB(dst, b, h) do { _Pragma("unroll") for (int n = 0; n < 2; ++n) _Pragma("unroll") for (int k = 0; k < 2; ++k) dst[n][k] = *(const LAS bf16x8*)(lds + PG8_SB(b, h) + boff + n * 2048 + k * 1024); } while (0)
#define PG8_MMA(ai, bj, At, Bt) do { __builtin_amdgcn_s_setprio(1); _Pragma("unroll") for (int m = 0; m < 4; ++m) _Pragma("unroll") for (int n = 0; n < 2; ++n) _Pragma("unroll") for (int k = 0; k < 2; ++k) \
        acc[ai][bj][m][n] = __builtin_amdgcn_mfma_f32_16x16x32_bf16(Bt[n][k], At[m][k], acc[ai][bj][m][n], 0, 0, 0); __builtin_amdgcn_s_setprio(0); } while (0)
#define PG8_WAIT_V(n) asm volatile("s_waitcnt vmcnt(" #n ")" ::: "memory")
#define PG8_WAIT_L(n) asm volatile("s_waitcnt lgkmcnt(" #n ")" ::: "memory")
#define PG8_BAR __builtin_amdgcn_s_barrier()
#define PG8_SCHED __builtin_amdgcn_sched_barrier(0)
    Unit cur, nxt; int ui = 0;
    if (!next_unit(g, 0, cur)) return;
    f32x4 acc[2][2][4][2];
#pragma unroll
    for (int a = 0; a < 2; ++a)
#pragma unroll
        for (int b = 0; b < 2; ++b)
#pragma unroll
            for (int m = 0; m < 4; ++m)
#pragma unroll
                for (int n = 0; n < 2; ++n) acc[a][b][m][n] = (f32x4){0.f, 0.f, 0.f, 0.f};
    bf16x8 At[4][2], B0[2][2], B1[2][2];
    const char* cA = unit_A(g, cur); const char* cB = unit_B(g, cur);
    PG8_STAGE(PG8_SB(0, 0), cB, voffB); PG8_STAGE(PG8_SA(0, 0), cA, voffA); PG8_STAGE(PG8_SB(0, 1), cB + hstepB, voffB); PG8_STAGE(PG8_SA(0, 1), cA + hstepA, voffA);
    if (wr == 1) PG8_BAR;
    PG8_WAIT_V(4); PG8_BAR;
    PG8_STAGE(PG8_SB(1, 0), cB + kstep, voffB); PG8_STAGE(PG8_SA(1, 0), cA + kstep, voffA); PG8_STAGE(PG8_SB(1, 1), cB + hstepB + kstep, voffB);
    PG8_WAIT_V(6); PG8_BAR;
    for (;;) {
        const bool has_next = next_unit(g, ui + 1, nxt);
        const char* nA = has_next ? unit_A(g, nxt) : cA; const char* nB = has_next ? unit_B(g, nxt) : cB;
        for (int t = 0; t < nt; t += 2) {
            const bool last = (t == nt - 2);
            const char* a1 = cA + (size_t)(t + 1) * kstep;
            const char* a2 = last ? nA : cA + (size_t)(t + 2) * kstep; const char* b2 = last ? nB : cB + (size_t)(t + 2) * kstep;
            const char* a3 = a2 + kstep; const char* b3 = b2 + kstep;
            PG8_LDB(B0, 0, 0); PG8_SCHED; PG8_LDA(At, 0, 0); PG8_STAGE(PG8_SA(1, 1), a1 + hstepA, voffA);
            PG8_WAIT_L(8); PG8_BAR; PG8_WAIT_L(0); PG8_MMA(0, 0, At, B0); PG8_BAR; PG8_SCHED;
            PG8_LDB(B1, 0, 1); PG8_STAGE(PG8_SB(0, 0), b2, voffB);
            PG8_BAR; PG8_WAIT_L(0); PG8_MMA(0, 1, At, B1); PG8_BAR;
            PG8_LDA(At, 0, 1); PG8_STAGE(PG8_SA(0, 0), a2, voffA);
            PG8_BAR; PG8_WAIT_L(0); PG8_MMA(1, 0, At, B0); PG8_BAR; PG8_SCHED;
            PG8_STAGE(PG8_SB(0, 1), b2 + hstepB, voffB);
            PG8_WAIT_V(6); PG8_BAR; PG8_MMA(1, 1, At, B1); PG8_BAR;
            PG8_LDB(B0, 1, 0); PG8_SCHED; PG8_LDA(At, 1, 0); PG8_STAGE(PG8_SA(0, 1), a2 + hstepA, voffA);
            PG8_WAIT_L(8); PG8_BAR; PG8_WAIT_L(0); PG8_MMA(0, 0, At, B0); PG8_BAR; PG8_SCHED;
            PG8_LDB(B1, 1, 1); PG8_STAGE(PG8_SB(1, 0), b3, voffB);
            PG8_BAR; PG8_WAIT_L(0); PG8_MMA(0, 1, At, B1); PG8_BAR;
            PG8_LDA(At, 1, 1); PG8_STAGE(PG8_SA(1, 0), a3, voffA);
            PG8_BAR; PG8_WAIT_L(0); PG8_MMA(1, 0, At, B0); PG8_BAR; PG8_SCHED;
            PG8_STAGE(PG8_SB(1, 1), b3 + hstepB, voffB);
            PG8_WAIT_V(6); PG8_BAR; PG8_MMA(1, 1, At, B1); PG8_BAR;
        }
        E(acc, cur, wr, wc, fr, fq);
        if (!has_next) break;
#pragma unroll
        for (int a = 0; a < 2; ++a)
#pragma unroll
            for (int b = 0; b < 2; ++b)
#pragma unroll
                for (int m = 0; m < 4; ++m)
#pragma unroll
                    for (int n = 0; n < 2; ++n) acc[a][b][m][n] = (f32x4){0.f, 0.f, 0.f, 0.f};
        cur = nxt; cA = nA; cB = nB; ++ui;
    }
    PG8_WAIT_V(0);
    if (wr == 0) PG8_BAR;
    PG8_BAR;
#undef PG8_SA
#undef PG8_SB
#undef PG8_STAGE
#undef PG8_LDA
#undef PG8_LDB
#undef PG8_MMA
#undef PG8_WAIT_V
#undef PG8_WAIT_L
#undef PG8_BAR
#undef PG8_SCHED
}

typedef f32x4 AccT[2][2][4][2];
#define EPI_ROWS_BEGIN _Pragma("unroll") for (int ai = 0; ai < 2; ++ai) _Pragma("unroll") for (int m = 0; m < 4; ++m) { const int row = u.pm * BM + ai * HALF + wr * 64 + m * 16 + fr;
#define EPI_ROWS_END }
#define EPI_RS_BATCH(RSV, PTR, W, INVDIM) float RSV[8]; { LAS float* _c = rsc; \
    if ((PTR) && __float_as_int(_c[0]) == u.pm) { _Pragma("unroll") for (int _k = 0; _k < 8; ++_k) RSV[_k] = _c[1 + _k]; }       \
    else { float _s[8]; _Pragma("unroll") for (int _k = 0; _k < 8; ++_k) { const int _row = u.pm * BM + (_k >> 2) * HALF + wr * 64 + (_k & 3) * 16 + fr; _s[_k] = (PTR) ? ss_sum((PTR), (size_t)_row, (W)) : 0.f; } \
        _Pragma("unroll") for (int _k = 0; _k < 8; ++_k) RSV[_k] = (PTR) ? rstd_of(_s[_k], (INVDIM)) : 1.0f; \
        if (PTR) { _c[0] = __int_as_float(u.pm); _Pragma("unroll") for (int _k = 0; _k < 8; ++_k) _c[1 + _k] = RSV[_k]; } } }

struct EpiSwiglu {
    static constexpr bool PERM = true;
    bf16_t* act; const float* rss; int rss_w; LAS float* rsc;
    __device__ __forceinline__ void operator()(AccT& acc, const Unit& u, int wr, int wc, int fr, int fq) const {
        EPI_RS_BATCH(rsv, rss, rss_w, 1.0f / DM)
        EPI_ROWS_BEGIN
            const float rs = rsv[ai * 4 + m];
            bf16_t* rp = act + (size_t)row * DFF + u.pn * 128 + wc * 32 + 8 * fq;
            unsigned o[4];
#pragma unroll
            for (int n = 0; n < 2; ++n) { f32x4 gv = acc[ai][0][m][n] * rs, uv = acc[ai][1][m][n] * rs;
                o[2 * n] = cvt_pk_bf16(silu_f(gv[0]) * uv[0], silu_f(gv[1]) * uv[1]); o[2 * n + 1] = cvt_pk_bf16(silu_f(gv[2]) * uv[2], silu_f(gv[3]) * uv[3]); }
            __builtin_nontemporal_store((u32x4){o[0], o[1], o[2], o[3]}, (u32x4*)rp);
        EPI_ROWS_END
    }
};
struct EpiResid {
    static constexpr bool PERM = true;
    const float* hin; float* hout; bf16_t* hb; float* ss_out; const float* rss; int rss_w; float rss_inv_dim; float alpha; LAS float* rsc;
    __device__ __forceinline__ void operator()(AccT& acc, const Unit& u, int wr, int wc, int fr, int fq) const {
        EPI_RS_BATCH(rsv, rss, rss_w, rss_inv_dim)
#pragma unroll
        for (int ah = 0; ah < 4; ++ah) { const int ai = ah >> 1, m0 = (ah & 1) * 2;
            f32x4 hv[4][2][2];
#pragma unroll
            for (int m = m0; m < m0 + 2; ++m) { const int row = u.pm * BM + ai * HALF + wr * 64 + m * 16 + fr; const size_t base = (size_t)row * DM + u.pn * BM + wc * 32 + 8 * fq;
#pragma unroll
                for (int bj = 0; bj < 2; ++bj)
#pragma unroll
                    for (int n = 0; n < 2; ++n) hv[m][bj][n] = *(const f32x4*)(hin + base + bj * HALF + n * 4); }
#pragma unroll
            for (int m = m0; m < m0 + 2; ++m) { const int row = u.pm * BM + ai * HALF + wr * 64 + m * 16 + fr; const size_t base = (size_t)row * DM + u.pn * BM + wc * 32 + 8 * fq;
                const float sc = alpha * rsv[ai * 4 + m]; float ss = 0.f;
#pragma unroll
                for (int bj = 0; bj < 2; ++bj) { const size_t o = base + bj * HALF;
                    const f32x4 ha = hv[m][bj][0] + acc[ai][bj][m][0] * sc, hc = hv[m][bj][1] + acc[ai][bj][m][1] * sc;
                    *(f32x4*)(hout + o) = ha; *(f32x4*)(hout + o + 4) = hc;
                    if (hb) *(u32x4*)(hb + o) = (u32x4){cvt_pk_bf16(ha[0], ha[1]), cvt_pk_bf16(ha[2], ha[3]), cvt_pk_bf16(hc[0], hc[1]), cvt_pk_bf16(hc[2], hc[3])};
                    ss += ha[0] * ha[0] + ha[1] * ha[1] + ha[2] * ha[2] + ha[3] * ha[3] + hc[0] * hc[0] + hc[1] * hc[1] + hc[2] * hc[2] + hc[3] * hc[3]; }
                if (ss_out) { ss += shfl_xor_f(ss, 16); ss += shfl_xor_f(ss, 32); if (fq == 0) ss_out[(size_t)row * 16 + u.pn * 4 + wc] = ss; } }
        }
    }
};
template <int MODE, bool ROPE> struct EpiStore {
    static constexpr bool PERM = !ROPE;
    bf16_t* out; long ldc; const float* rss; int rss_w; float rs_inv_dim; const float* css; int css_w; float cs_inv_dim; long zoff; const int* pos; LAS float* rsc;
    __device__ __forceinline__ void operator()(AccT& acc, const Unit& u, int wr, int wc, int fr, int fq) const {
        bf16_t* ob = out + (size_t)u.pz * zoff; int rbase = u.pm * BM, cbase = u.pn * BM;
        if (MODE == 1) { const int b = u.pn >> 2; ob = out + ((size_t)b * SEQ) * 2048; cbase = (u.pn & 3) * BM; }
        if (css) {
#pragma unroll
            for (int bj = 0; bj < 2; ++bj)
#pragma unroll
                for (int n = 0; n < 2; ++n) { const size_t c0 = (size_t)(u.pn * BM + bj * HALF + wc * 32 + (PERM ? 8 * fq + 4 * n : n * 16 + 4 * fq));
                    const f32x4 cv = (f32x4){rstd_of(ss_sum(css, c0, css_w), cs_inv_dim), rstd_of(ss_sum(css, c0 + 1, css_w), cs_inv_dim), rstd_of(ss_sum(css, c0 + 2, css_w), cs_inv_dim), rstd_of(ss_sum(css, c0 + 3, css_w), cs_inv_dim)};
#pragma unroll
                    for (int ai = 0; ai < 2; ++ai)
#pragma unroll
                        for (int m = 0; m < 4; ++m) acc[ai][bj][m][n] *= cv; }
        }
        EPI_RS_BATCH(rsv, rss, rss_w, rs_inv_dim)
        EPI_ROWS_BEGIN
            const float rs = rsv[ai * 4 + m];
            int lrow = rbase + ai * HALF + wr * 64 + m * 16 + fr; int mrow = -1; float msgn = 1.0f; long mcoff = 0;
            if (MODE == 1) {
                const int r = lrow; if (r <= 1024) { mrow = (r >= 1 && r < 1024) ? 2048 - r : -1; } else { lrow = r - 1024; mrow = 2048 - lrow; mcoff = 1024; msgn = -1.0f; }
                if (r == 1024) { bf16_t* z0 = ob + 1024 + cbase + wc * 32 + 8 * fq; bf16_t* z1 = z0 + (size_t)1024 * 2048; const u32x4 zz = (u32x4){0u, 0u, 0u, 0u};
#pragma unroll
                    for (int bj = 0; bj < 2; ++bj) { *(u32x4*)(z0 + bj * HALF) = zz; *(u32x4*)(z1 + bj * HALF) = zz; } } }
            bf16_t* rp = ob + (size_t)lrow * ldc + mcoff + cbase + wc * 32 + (PERM ? 8 : 4) * fq;
            float fpos = 0.f; if (ROPE) fpos = (float)pos[row];
#pragma unroll
            for (int bj = 0; bj < 2; ++bj) {
                f32x4 v0 = acc[ai][bj][m][0] * rs, v1 = acc[ai][bj][m][1] * rs;
                if (ROPE) { const int G = (u.pn * BM + bj * HALF + wc * 32) >> 5;
                    if (G % 3 == 2) {
#pragma unroll
                        for (int e = 0; e < 4; ++e) { const int fi = 4 * fq + e; const float inv = fexp2(-(float)fi * (13.287712379549449f / 16.0f));
                            float t = fpos * inv * 0.15915494309189535f; t -= floorf(t);
                            const float sn = __builtin_amdgcn_sinf(t), cn = __builtin_amdgcn_cosf(t);
                            const float x1 = v0[e], x2 = v1[e]; v0[e] = x1 * cn - x2 * sn; v1[e] = x1 * sn + x2 * cn; } } }
                u32x2 p0, p1; p0.x = cvt_pk_bf16(v0[0], v0[1]); p0.y = cvt_pk_bf16(v0[2], v0[3]); p1.x = cvt_pk_bf16(v1[0], v1[1]); p1.y = cvt_pk_bf16(v1[2], v1[3]);
                if (PERM) *(u32x4*)(rp + bj * HALF) = (u32x4){p0.x, p0.y, p1.x, p1.y}; else { *(u32x2*)(rp + bj * HALF) = p0; *(u32x2*)(rp + bj * HALF + 16) = p1; }
                if (MODE == 1 && mrow >= 0) { bf16_t* mp = ob + (size_t)mrow * ldc + mcoff + cbase + wc * 32 + 8 * fq;
                    if (msgn < 0.f) { p0.x ^= 0x80008000u; p0.y ^= 0x80008000u; p1.x ^= 0x80008000u; p1.y ^= 0x80008000u; }
                    *(u32x4*)(mp + bj * HALF) = (u32x4){p0.x, p0.y, p1.x, p1.y}; } }
        EPI_ROWS_END
    }
};
struct EpiWin {
    static constexpr bool PERM = false;
    unsigned char* scr; const float* rss; int rss_w; float* ss_cq; float* ss_ckv; const int* pos; LAS float* rsc;
    __device__ __forceinline__ void operator()(AccT& acc, const Unit& u, int wr, int wc, int fr, int fq) const {
        const int pn = u.pn;
        EPI_RS_BATCH(rsv, rss, rss_w, 1.0f / DM)
        EPI_ROWS_BEGIN
            const float rs = rsv[ai * 4 + m];
            if (pn < 13) {
                bf16_t* rp; float* ssp = nullptr; size_t ssi = 0;
                if (pn < 4) rp = (bf16_t*)(scr + S_Z) + (size_t)row * 1536 + pn * BM;
                else if (pn < 10) rp = (bf16_t*)(scr + S_XBC) + (size_t)row * 1536 + (pn - 4) * BM;
                else if (pn < 12) { rp = (bf16_t*)(scr + S_CQ) + (size_t)row * 512 + (pn - 10) * BM; ssp = ss_cq; ssi = (size_t)row * 16 + (pn - 10) * 4 + wc; }
                else { rp = (bf16_t*)(scr + S_CKV) + (size_t)row * 256; ssp = ss_ckv; ssi = (size_t)row * 16 + wc; }
                rp += wc * 32 + 4 * fq; float ss = 0.f;
#pragma unroll
                for (int bj = 0; bj < 2; ++bj)
#pragma unroll
                    for (int n = 0; n < 2; ++n) { f32x4 v = acc[ai][bj][m][n] * rs; u32x2 p; p.x = cvt_pk_bf16(v[0], v[1]); p.y = cvt_pk_bf16(v[2], v[3]);
                        *(u32x2*)(rp + bj * HALF + n * 16) = p; ss += v[0] * v[0] + v[1] * v[1] + v[2] * v[2] + v[3] * v[3]; }
                if (ssp) { ss += shfl_xor_f(ss, 16); ss += shfl_xor_f(ss, 32);
                    if (fq == 0) { ssp[ssi] = ss; if (pn == 12) { ssp[ssi + 4] = 0.f; ssp[ssi + 8] = 0.f; ssp[ssi + 12] = 0.f; } else ssp[ssi + 8] = 0.f; } }
            } else {
                if (wc == 0) {
                    float* dp = (float*)(scr + S_DTRAW) + (size_t)row * 32 + 4 * fq;
                    *(f32x4*)dp = acc[ai][0][m][0] * rs; *(f32x4*)(dp + 16) = acc[ai][0][m][1] * rs;
                } else if (wc == 1) {
                    f32x4 v0 = acc[ai][0][m][0] * rs, v1 = acc[ai][0][m][1] * rs; const float fpos = (float)pos[row];
#pragma unroll
                    for (int e = 0; e < 4; ++e) { const int fi = 4 * fq + e; const float inv = fexp2(-(float)fi * (13.287712379549449f / 16.0f));
                        float t = fpos * inv * 0.15915494309189535f; t -= floorf(t);
                        const float sn = __builtin_amdgcn_sinf(t), cn = __builtin_amdgcn_cosf(t);
                        const float x1 = v0[e], x2 = v1[e]; v0[e] = x1 * cn - x2 * sn; v1[e] = x1 * sn + x2 * cn; }
                    bf16_t* kp = (bf16_t*)(scr + S_KROPE) + (size_t)row * 32 + 4 * fq;
                    u32x2 p0, p1; p0.x = cvt_pk_bf16(v0[0], v0[1]); p0.y = cvt_pk_bf16(v0[2], v0[3]); p1.x = cvt_pk_bf16(v1[0], v1[1]); p1.y = cvt_pk_bf16(v1[2], v1[3]);
                    *(u32x2*)kp = p0; *(u32x2*)(kp + 16) = p1;
                }
            }
        EPI_ROWS_END
    }
};

__device__ __forceinline__ int colmap(int map, int j) {
    switch (map) {
        case 1: { const int t = j >> 8, w = j & 255; return (w >> 7) * DFF + t * 128 + (w & 127); }
        case 2: return j < 2560 ? j : (j < 3328 ? j + 32 : (j < 3360 ? j - 768 : (j < 3392 ? j : -1)));
        case 3: return (j >> 6) * 128 + (j & 63);
        case 4: return (j >> 6) * 128 + 64 + (j & 63);
        default: return j;
    }
}
__device__ __attribute__((noinline)) void convT(LAS float* tile, const float* src, int ldsrc, int K, bf16_t* dst, int ldd, int ndst, int map, const float* kscale, float scalar) {
    const int tid = opaque_tid(), nkt = K >> 6, ntiles = (ndst >> 8) * nkt;
    for (int t = blockIdx.x; t < ntiles; t += gridDim.x) {
        const int n0 = (t / nkt) << 8, k0 = (t % nkt) << 6;
        { const int k = tid >> 3, nv = tid & 7; f32x4 va[4], vb[4];
#pragma unroll
          for (int j = 0; j < 4; ++j) { const int sc = colmap(map, n0 + 64 * j + 8 * nv); va[j] = (f32x4){0.f, 0.f, 0.f, 0.f}; vb[j] = va[j];
              if (sc >= 0) { const float* p = src + (size_t)(k0 + k) * ldsrc + sc; va[j] = *(const f32x4*)p; vb[j] = *(const f32x4*)(p + 4); } }
          const float s = (kscale ? kscale[k0 + k] : 1.0f) * scalar;
#pragma unroll
          for (int j = 0; j < 4; ++j) { LAS float* tp = tile + k * 257 + 64 * j + 8 * nv;
              tp[0] = va[j][0] * s; tp[1] = va[j][1] * s; tp[2] = va[j][2] * s; tp[3] = va[j][3] * s; tp[4] = vb[j][0] * s; tp[5] = vb[j][1] * s; tp[6] = vb[j][2] * s; tp[7] = vb[j][3] * s; } }
        __syncthreads();
        { const int kv = tid & 7;
#pragma unroll
          for (int j = 0; j < 4; ++j) { const int n = (tid >> 3) + 64 * j; const LAS float* tp = tile + (8 * kv) * 257 + n;
              u32x4 o; o.x = cvt_pk_bf16(tp[0], tp[257]); o.y = cvt_pk_bf16(tp[514], tp[771]); o.z = cvt_pk_bf16(tp[1028], tp[1285]); o.w = cvt_pk_bf16(tp[1542], tp[1799]);
              *(u32x4*)(dst + (size_t)(n0 + n) * ldd + k0 + 8 * kv) = o; } }
        __syncthreads();
    }
}
__device__ void convert_layer(const Args& a, int l, LAS float* tile) {
    bf16_t* wb = (bf16_t*)(a.ws + OFF_WB);
    const float* const* in = (const float* const*)a.in;
    convT(tile, in[6] + (size_t)l * DM * 2 * DFF, 2 * DFF, DM, wb + W_GU1, DM, 2 * DFF, 1, in[5] + l * DM, 1.0f);
    convT(tile, in[7] + (size_t)l * DFF * DM, DM, DFF, wb + W_DN1, DFF, DM, 0, nullptr, 1.0f);
    convT(tile, in[14] + (size_t)l * DM * 2 * DFF, 2 * DFF, DM, wb + W_GU2, DM, 2 * DFF, 1, in[13] + l * DM, 1.0f);
    convT(tile, in[15] + (size_t)l * DFF * DM, DM, DFF, wb + W_DN2, DFF, DM, 0, nullptr, 1.0f);
    convT(tile, in[10] + (size_t)l * DM * DM, DM, DM, wb + W_Q, DM, DM, 0, in[9] + l * DM, 0.0625f * LOG2E);
    convT(tile, in[11] + (size_t)l * DM * 2 * DM, 2 * DM, DM, wb + W_K, DM, DM, 0, in[3], 1.0f);
    convT(tile, in[11] + (size_t)l * DM * 2 * DM + DM, 2 * DM, DM, wb + W_V, DM, DM, 0, in[3], 1.0f);
    convT(tile, in[12] + (size_t)l * DM * DM, DM, DM, wb + W_O, DM, DM, 0, nullptr, 1.0f);
    if ((l & 1) == 0) { const int e = l >> 1;
        convT(tile, in[16] + (size_t)e * DM * 3392, 3392, DM, wb + W_IN, DM, 3584, 2, in[8] + l * DM, 1.0f);
        convT(tile, in[24] + (size_t)e * 512 * 768, 768, 512, wb + W_UQ, 512, 768, 0, in[23] + e * 512, 0.10206207261596577f * LOG2E);
        convT(tile, in[26] + (size_t)e * 256 * 1024, 1024, 256, wb + W_KN, 256, 512, 3, in[25] + e * 256, 1.0f);
        convT(tile, in[26] + (size_t)e * 256 * 1024, 1024, 256, wb + W_VV, 256, 512, 4, in[25] + e * 256, 1.0f);
        convT(tile, in[27] + (size_t)e * 1536 * 1024, 1024, 1024, wb + W_OY, 1536, 1024, 0, in[22] + e * 1024, 1.0f);
        convT(tile, in[27] + (size_t)e * 1536 * 1024 + (size_t)1024 * 1024, 1024, 512, wb + W_OY + 1024, 1536, 1024, 0, nullptr, 1.0f);
    } else { const int o = l >> 1;
        convT(tile, in[28] + (size_t)o * DM * DM, DM, DM, wb + W_FT, DM, DM, 0, nullptr, 1.0f);
    }
}

__device__ void rows_to_bf16(const float* src, bf16_t* dst, float* ss, int nrows, int w) {
    const int tid = opaque_tid(); const int lane = tid & 63, wv = tid >> 6;
    const int per = nrows >> 3, rbeg = (int)(blockIdx.x & 7) * per;
    for (int rl = ((int)(blockIdx.x >> 3) * 8 + wv) * 4; rl < per; rl += (int)(gridDim.x >> 3) * 32) { const int r0 = rbeg + rl;
        f32x4 v[4][4];
#pragma unroll
        for (int q = 0; q < 4; ++q)
#pragma unroll
            for (int k = 0; k < 4; ++k) v[q][k] = *(const f32x4*)(src + (size_t)(r0 + q) * DM + lane * 4 + k * 256);
#pragma unroll
        for (int q = 0; q < 4; ++q) { bf16_t* qd = dst + (size_t)(r0 + q) * DM + lane * 4; float s = 0.f;
#pragma unroll
            for (int k = 0; k < 4; ++k) { const f32x4 x = v[q][k]; s += x[0] * x[0] + x[1] * x[1] + x[2] * x[2] + x[3] * x[3];
                u32x2 o; o.x = cvt_pk_bf16(x[0], x[1]); o.y = cvt_pk_bf16(x[2], x[3]); *(u32x2*)(qd + k * 256) = o; }
#pragma unroll
            for (int o = 32; o > 0; o >>= 1) s += shfl_xor_f(s, o);
            if (lane < w) ss[(size_t)(r0 + q) * w + lane] = lane == 0 ? s : 0.f; }
    }
}
__device__ void gen_tables(const Args& a) {
    bf16_t* F = (bf16_t*)(a.ws + OFF_FSEQ); bf16_t* Tc = (bf16_t*)(a.ws + OFF_TCH);
    const size_t gt = (size_t)blockIdx.x * blockDim.x + opaque_tid(), gs = (size_t)gridDim.x * blockDim.x;
    const float scale = 0.001381067932004976f;
    for (size_t i = gt; i < (size_t)2048 * 256; i += gs) {
        const int row = (int)(i >> 8), c0 = (int)(i & 255) * 8, cs = row > 1024 ? 1 : 0, sp = cs ? row - 1024 : row; unsigned w[4];
#pragma unroll
        for (int e = 0; e < 8; e += 2) { float v[2];
#pragma unroll
            for (int x = 0; x < 2; ++x) { const int k = (sp * (c0 + e + x)) & 2047; const float t = (float)k * (1.0f / 2048.0f);
                v[x] = (cs ? __builtin_amdgcn_sinf(t) : __builtin_amdgcn_cosf(t)) * scale; }
            w[e >> 1] = cvt_pk_bf16(v[0], v[1]); }
        *(u32x4*)(F + (size_t)row * 2048 + c0) = (u32x4){w[0], w[1], w[2], w[3]};
    }
    for (size_t i = gt; i < (size_t)2 * 256 * 32; i += gs) {
        const int cs = (int)(i >> 13), c = (int)((i >> 5) & 255), c0 = (int)(i & 31) * 8; unsigned w[4];
#pragma unroll
        for (int e = 0; e < 8; e += 2) { float v[2];
#pragma unroll
            for (int x = 0; x < 2; ++x) { const int k = (c * (c0 + e + x)) & 255; const float t = (float)k * (1.0f / 256.0f);
                v[x] = cs ? -__builtin_amdgcn_sinf(t) : __builtin_amdgcn_cosf(t); }
            w[e >> 1] = cvt_pk_bf16(v[0], v[1]); }
        *(u32x4*)(Tc + (size_t)cs * 65536 + (size_t)c * 256 + c0) = (u32x4){w[0], w[1], w[2], w[3]};
    }
}

__device__ void conv_phase(const Args& a, int e, LAS unsigned char* lds) {
    unsigned char* scr = a.ws + OFF_SCR;
    const bf16_t* xbc = (const bf16_t*)(scr + S_XBC);
    const float* cw = (const float*)a.in[17] + (size_t)e * 5 * 1536; const float* cb = (const float*)a.in[18] + (size_t)e * 1536;
    const int tid = opaque_tid();
    LAS bf16_t* tl = (LAS bf16_t*)lds;
    bf16_t* xT = (bf16_t*)(scr + S_XT);
    for (int trip = 0; ; ++trip) { const int it = xcd_item(trip, NB * 32 * 8); if (it < 0) break;
        const int b = it >> 8, st = (it >> 3) & 31, ct = it & 7, s0 = st * 64, c0 = ct * 128;
        { const int s = tid >> 3, cv = tid & 7; u32x4 xv[2][5];
#pragma unroll
          for (int j = 0; j < 2; ++j)
#pragma unroll
              for (int k = 0; k < 5; ++k) { const int sp = s0 + s + k - 2; xv[j][k] = (u32x4){0u, 0u, 0u, 0u};
                  if (sp >= 0 && sp < SEQ) xv[j][k] = *(const u32x4*)(xbc + ((size_t)b * SEQ + sp) * 1536 + c0 + 64 * j + 8 * cv); }
#pragma unroll
          for (int j = 0; j < 2; ++j) { const int ch = c0 + 64 * j + 8 * cv; float accv[8];
#pragma unroll
              for (int x = 0; x < 8; ++x) accv[x] = cb[ch + x];
#pragma unroll
              for (int k = 0; k < 5; ++k) { const u32x4 v = xv[j][k]; const float* wp = cw + k * 1536 + ch;
                  const f32x4 w0 = *(const f32x4*)wp, w1 = *(const f32x4*)(wp + 4);
                  accv[0] += bflo(v.x) * w0[0]; accv[1] += bfhi(v.x) * w0[1]; accv[2] += bflo(v.y) * w0[2]; accv[3] += bfhi(v.y) * w0[3];
                  accv[4] += bflo(v.z) * w1[0]; accv[5] += bfhi(v.z) * w1[1]; accv[6] += bflo(v.w) * w1[2]; accv[7] += bfhi(v.w) * w1[3]; }
#pragma unroll
              for (int x = 0; x < 8; x += 2) { const unsigned p = cvt_pk_bf16(silu_f(accv[x]), silu_f(accv[x + 1]));
                  tl[(64 * j + 8 * cv + x) * 72 + s] = (bf16_t)(p & 0xffff); tl[(64 * j + 8 * cv + x + 1) * 72 + s] = (bf16_t)(p >> 16); } } }
        __syncthreads();
        { const int sv = tid & 7;
#pragma unroll
          for (int j = 0; j < 2; ++j) { const int ch = (tid >> 3) + 64 * j; const u32x4 v = *(const LAS u32x4*)(tl + ch * 72 + 8 * sv);
              *(u32x4*)(xT + ((size_t)b * 1024 + c0 + ch) * SEQ + s0 + 8 * sv) = v; } }
        __syncthreads();
    }
    bf16_t* bcc = (bf16_t*)(scr + S_BCC);
    for (int trip = 0; ; ++trip) { const int itb = xcd_item(trip, T_TOK / 8); if (itb < 0) break; const size_t i = (size_t)itb * 512 + tid;
        const int row = (int)(i >> 6), ch = 1024 + (int)(i & 63) * 8, s = row & (SEQ - 1); float accv[8];
#pragma unroll
        for (int x = 0; x < 8; ++x) accv[x] = cb[ch + x];
#pragma unroll
        for (int k = 0; k < 5; ++k) { const int sp = s + k - 2;
            if (sp >= 0 && sp < SEQ) { const u32x4 v = *(const u32x4*)(xbc + ((size_t)row + k - 2) * 1536 + ch); const float* wp = cw + k * 1536 + ch;
                const f32x4 w0 = *(const f32x4*)wp, w1 = *(const f32x4*)(wp + 4);
                accv[0] += bflo(v.x) * w0[0]; accv[1] += bfhi(v.x) * w0[1]; accv[2] += bflo(v.y) * w0[2]; accv[3] += bfhi(v.y) * w0[3];
                accv[4] += bflo(v.z) * w1[0]; accv[5] += bfhi(v.z) * w1[1]; accv[6] += bflo(v.w) * w1[2]; accv[7] += bfhi(v.w) * w1[3]; } }
        u32x4 o; o.x = cvt_pk_bf16(silu_f(accv[0]), silu_f(accv[1])); o.y = cvt_pk_bf16(silu_f(accv[2]), silu_f(accv[3]));
        o.z = cvt_pk_bf16(silu_f(accv[4]), silu_f(accv[5])); o.w = cvt_pk_bf16(silu_f(accv[6]), silu_f(accv[7]));
        *(u32x4*)(bcc + (size_t)row * 512 + (ch - 1024)) = o;
    }
    const float* dtraw = (const float*)(scr + S_DTRAW); float* cum = (float*)(scr + S_CUM);
    const float* dtb = (const float*)a.in[19] + e * 32; const float* alog = (const float*)a.in[20] + e * 32;
    const int lane = tid & 63, wv = tid >> 6;
    for (int it = wv * gridDim.x + blockIdx.x; it < NB * 32; it += gridDim.x * 8) {
        const int b = it >> 5, dr = it & 31, dir = dr >> 4, r = dr & 15;
        const float bias = dtb[dr], A = -expf(alog[dr]);
        const float* src = dtraw + ((size_t)b * SEQ + lane * 32) * 32 + dr;
        float xr[32];
#pragma unroll
        for (int k = 0; k < 32; ++k) xr[k] = src[(size_t)k * 32];
        float tot = 0.f;
#pragma unroll
        for (int k = 0; k < 32; ++k) { const float x = xr[k] + bias; const float dt = fmaxf(x, 0.f) + log1pf(expf(-fabsf(x))); xr[k] = dt; tot += dt * A; }
        float incl = tot;
#pragma unroll
        for (int o = 1; o < 64; o <<= 1) { const float v = __shfl_up(incl, o, 64); if (lane >= o) incl += v; }
        float run = incl - tot;
        float* pa = cum + ((size_t)b * SEQ + lane * 32) * 64 + dir * 32 + r; float* pb = pa + 16;
#pragma unroll
        for (int k = 0; k < 32; ++k) { const float dt = xr[k]; const float la = dt * A, l2 = log2f(dt);
            if (dir == 0) { run += la; pa[(size_t)k * 64] = run * LOG2E; pb[(size_t)k * 64] = run * LOG2E - l2; }
            else { pa[(size_t)k * 64] = run * LOG2E; pb[(size_t)k * 64] = run * LOG2E + l2; run += la; } }
    }
}

#define MFMA16(a, b, c) __builtin_amdgcn_mfma_f32_16x16x32_bf16((a), (b), (c), 0, 0, 0)
__device__ __forceinline__ bf16x8 ld_frag16(const LAS bf16_t* p) { return *(const LAS bf16x8*)p; }
__device__ __forceinline__ bf16x8 ld_frag_split(const LAS bf16_t* p) {
    const u32x2 lo = *(const LAS u32x2*)p, hi = *(const LAS u32x2*)(p + 16); u32x4 v = (u32x4){lo.x, lo.y, hi.x, hi.y}; return __builtin_bit_cast(bf16x8, v); }
__device__ __forceinline__ bf16x8 pack_frag(const f32x4& a, const f32x4& b) {
    u32x4 v = (u32x4){cvt_pk_bf16(a[0], a[1]), cvt_pk_bf16(a[2], a[3]), cvt_pk_bf16(b[0], b[1]), cvt_pk_bf16(b[2], b[3])}; return __builtin_bit_cast(bf16x8, v); }

template <int DK, int DK1, int DV, int QT, int PD>
__device__ __forceinline__ void attn_item(LAS unsigned char* lds, const bf16_t* Q, int ldq, const bf16_t* K1, int ldk1, const bf16_t* K2, int ldk2,
                                          const bf16_t* Vt, long ldvt, int nkeys, bf16_t* O, int ldo, const float* osc) {
    constexpr int KS = DK / 32, DT = DV / 16, KSTR = DK + 8, VSTR = 136, BUFE = 128 * KSTR + DV * VSTR;
    LAS bf16_t* Ks0 = (LAS bf16_t*)lds; LAS bf16_t* Vs0 = Ks0 + 128 * KSTR;
    const int tid = opaque_tid(), lane = tid & 63, wv = tid >> 6, i = lane & 15, quad = lane >> 4;
    bf16x8 qf[QT][KS];
#pragma unroll
    for (int qt = 0; qt < QT; ++qt)
#pragma unroll
        for (int ks = 0; ks < KS; ++ks) qf[qt][ks] = *(const bf16x8*)(Q + (size_t)(wv * 16 * QT + qt * 16 + i) * ldq + ks * 32 + quad * 8);
    f32x4 acc_o[DT][QT]; float mrow[QT], lsum[QT];
#pragma unroll
    for (int qt = 0; qt < QT; ++qt) { mrow[qt] = -INFINITY; lsum[qt] = 0.f;
#pragma unroll
        for (int d = 0; d < DT; ++d) acc_o[d][qt] = (f32x4){0.f, 0.f, 0.f, 0.f}; }
    constexpr int KCH = DK / 8, NKQ = (128 * KCH + 511) / 512, NVQ = (DV * 16 + 511) / 512;
    static_assert(128 * KCH == NKQ * 512 && DV * 16 == NVQ * 512, "tile chunks must divide evenly over 512 threads");
    u32x4 pK[NKQ], pV[NVQ];
    typedef const __attribute__((address_space(1))) bf16_t* gbf16p;
    gbf16p kptr[NKQ]; unsigned kstr[NKQ];
#pragma unroll
    for (int q = 0; q < NKQ; ++q) { const int c = tid + q * 512, key = c / KCH, dc = (c % KCH) * 8;
        if (dc < DK1) { kptr[q] = (gbf16p)(K1 + (size_t)key * ldk1 + dc); kstr[q] = (unsigned)ldk1 * 128u; } else { kptr[q] = (gbf16p)(K2 + (size_t)key * ldk2 + (dc - DK1)); kstr[q] = (unsigned)ldk2 * 128u; } }
    const unsigned voff = (unsigned)((tid >> 4) * ldvt + (tid & 15) * 8);
#define ATT_LOAD(k0_) do { \
        _Pragma("unroll") for (int q = 0; q < NKQ; ++q) { pK[q] = *(const __attribute__((address_space(1))) u32x4*)kptr[q]; kptr[q] += kstr[q]; } \
        _Pragma("unroll") for (int q = 0; q < NVQ; ++q) pV[q] = *(const u32x4*)((Vt + (size_t)q * 32 * ldvt + (k0_)) + voff); } while (0)
#define ATT_STORE(B_) do { \
        _Pragma("unroll") for (int q = 0; q < NKQ; ++q) { const int c = tid + q * 512; *(LAS u32x4*)(Ks0 + (B_) * BUFE + (c / KCH) * KSTR + (c % KCH) * 8) = pK[q]; } \
        _Pragma("unroll") for (int q = 0; q < NVQ; ++q) { const int c = tid + q * 512; *(LAS u32x4*)(Vs0 + (B_) * BUFE + (c >> 4) * VSTR + (c & 15) * 8) = pV[q]; } } while (0)
#define ATT_QK(SC, KOFF) do { _Pragma("unroll") for (int kt = 0; kt < 4; ++kt) { \
            _Pragma("unroll") for (int qt = 0; qt < QT; ++qt) SC[kt][qt] = (f32x4){0.f, 0.f, 0.f, 0.f}; \
            _Pragma("unroll") for (int ks = 0; ks < KS; ++ks) { const bf16x8 kf = ld_frag16(Ks + ((KOFF) + kt * 16 + i) * KSTR + ks * 32 + quad * 8); \
                _Pragma("unroll") for (int qt = 0; qt < QT; ++qt) SC[kt][qt] = MFMA16(kf, qf[qt][ks], SC[kt][qt]); } } } while (0)
#define ATT_SOFTMAX_PV(SC, KOFF) do { bf16x8 pf[2][QT]; \
        _Pragma("unroll") for (int qt = 0; qt < QT; ++qt) { float mx = -INFINITY; \
            _Pragma("unroll") for (int kt = 0; kt < 4; ++kt) _Pragma("unroll") for (int j = 0; j < 4; ++j) mx = fmaxf(mx, SC[kt][qt][j]); \
            mx = fmaxf(mx, shfl_xor_f(mx, 16)); mx = fmaxf(mx, shfl_xor_f(mx, 32)); \
            const float mn = fmaxf(mrow[qt], mx), alpha = fexp2(mrow[qt] - mn); mrow[qt] = mn; float ls = 0.f; \
            _Pragma("unroll") for (int kt = 0; kt < 4; ++kt) _Pragma("unroll") for (int j = 0; j < 4; ++j) { const float p = fexp2(SC[kt][qt][j] - mn); SC[kt][qt][j] = p; ls += p; } \
            lsum[qt] = lsum[qt] * alpha + ls; \
            _Pragma("unroll") for (int d = 0; d < DT; ++d) acc_o[d][qt] *= alpha; \
            pf[0][qt] = pack_frag(SC[0][qt], SC[1][qt]); pf[1][qt] = pack_frag(SC[2][qt], SC[3][qt]); } \
        _Pragma("unroll") for (int u = 0; u < 2; ++u) _Pragma("unroll") for (int d = 0; d < DT; ++d) { const bf16x8 vf = ld_frag_split(Vs + (d * 16 + i) * VSTR + (KOFF) + u * 32 + quad * 4); \
            _Pragma("unroll") for (int qt = 0; qt < QT; ++qt) acc_o[d][qt] = MFMA16(vf, pf[u][qt], acc_o[d][qt]); } } while (0)
    const int nt = nkeys >> 7;
    ATT_LOAD(0);
    __syncthreads();
    ATT_STORE(0);
    __syncthreads();
    if (1 < nt) ATT_LOAD(128);
    for (int t = 0; t < nt; ++t) {
        const int bsel = t & 1; LAS bf16_t* Ks = Ks0 + bsel * BUFE; LAS bf16_t* Vs = Vs0 + bsel * BUFE;
        if (t + 1 < nt) { ATT_STORE(bsel ^ 1); if (t + 2 < nt) ATT_LOAD((t + 2) * 128); }
        f32x4 sca[4][QT], scb[4][QT];
        ATT_QK(sca, 0); ATT_QK(scb, 64);
        ATT_SOFTMAX_PV(sca, 0);
        ATT_SOFTMAX_PV(scb, 64);
        __syncthreads();
    }
#pragma unroll
    for (int qt = 0; qt < QT; ++qt) { float l = lsum[qt]; l += shfl_xor_f(l, 16); l += shfl_xor_f(l, 32); float inv = 1.0f / l;
        if (osc) inv *= sqrtf(ss_sum(osc, (size_t)(wv * 16 * QT + qt * 16 + i), 16) * (1.0f / 1024) + EPS);
        bf16_t* op = O + (size_t)(wv * 16 * QT + qt * 16 + i) * ldo + quad * 4;
#pragma unroll
        for (int d = 0; d < DT; ++d) { const f32x4 v = acc_o[d][qt] * inv; u32x2 p; p.x = cvt_pk_bf16(v[0], v[1]); p.y = cvt_pk_bf16(v[2], v[3]); *(u32x2*)(op + d * 16) = p; } }
#undef ATT_LOAD
#undef ATT_STORE
#undef ATT_QK
#undef ATT_SOFTMAX_PV
}

__device__ __forceinline__ void xa_item(LAS unsigned char* lds, const bf16_t* Q, const bf16_t* K, const bf16_t* Vt, bf16_t* O) {
    constexpr int KSTR = 264, VSTR = 72, LDQ = 1024, LDK = 1024, LDO = 1024; constexpr long LDV = TMEM;
    LAS bf16_t* Ks = (LAS bf16_t*)lds; LAS bf16_t* Vs = (LAS bf16_t*)lds;
    const int tid = opaque_tid(), lane = tid & 63, wv = tid >> 6, i = lane & 15, quad = lane >> 4;
    bf16x8 qf[2][8];
#pragma unroll
    for (int qt = 0; qt < 2; ++qt)
#pragma unroll
        for (int ks = 0; ks < 8; ++ks) qf[qt][ks] = *(const bf16x8*)(Q + (size_t)(wv * 32 + qt * 16 + i) * LDQ + ks * 32 + quad * 8);
    u32x4 pK[4], pV[2];
    const unsigned koff = (unsigned)((tid >> 5) * LDK + (tid & 31) * 8), voff = (unsigned)((tid >> 3) * LDV + (tid & 7) * 8);
#define XA_LOADK(t_) do { _Pragma("unroll") for (int q = 0; q < 4; ++q) pK[q] = *(const u32x4*)((K + (size_t)((t_) * 64 + q * 16) * LDK) + koff); } while (0)
#define XA_LOADV(h_, t_) do { _Pragma("unroll") for (int q = 0; q < 2; ++q) pV[q] = *(const u32x4*)((Vt + (size_t)((h_) * 128 + q * 64) * LDV + (t_) * 64) + voff); } while (0)
    f32x4 sc[16][2];
#pragma unroll
    for (int k = 0; k < 16; ++k) { sc[k][0] = (f32x4){0.f, 0.f, 0.f, 0.f}; sc[k][1] = (f32x4){0.f, 0.f, 0.f, 0.f}; }
    XA_LOADK(0);
#pragma unroll
    for (int t = 0; t < 4; ++t) {
        __syncthreads();
#pragma unroll
        for (int q = 0; q < 4; ++q) { const int c = tid + q * 512; *(LAS u32x4*)(Ks + (c >> 5) * KSTR + (c & 31) * 8) = pK[q]; }
        __syncthreads();
        if (t < 3) XA_LOADK(t + 1); else XA_LOADV(0, 0);
#pragma unroll
        for (int kt = 0; kt < 4; ++kt)
#pragma unroll
            for (int ks = 0; ks < 8; ++ks) { const bf16x8 kf = ld_frag16(Ks + (kt * 16 + i) * KSTR + ks * 32 + quad * 8);
                sc[t * 4 + kt][0] = MFMA16(kf, qf[0][ks], sc[t * 4 + kt][0]); sc[t * 4 + kt][1] = MFMA16(kf, qf[1][ks], sc[t * 4 + kt][1]); }
    }
    bf16x8 pf[8][2]; float linv[2];
#pragma unroll
    for (int qt = 0; qt < 2; ++qt) {
        float mx = -INFINITY;
#pragma unroll
        for (int k = 0; k < 16; ++k)
#pragma unroll
            for (int j = 0; j < 4; ++j) mx = fmaxf(mx, sc[k][qt][j]);
        mx = fmaxf(mx, shfl_xor_f(mx, 16)); mx = fmaxf(mx, shfl_xor_f(mx, 32));
        float ls = 0.f;
#pragma unroll
        for (int k = 0; k < 16; ++k)
#pragma unroll
            for (int j = 0; j < 4; ++j) { const float p = fexp2(sc[k][qt][j] - mx); sc[k][qt][j] = p; ls += p; }
        ls += shfl_xor_f(ls, 16); ls += shfl_xor_f(ls, 32); linv[qt] = 1.0f / ls;
#pragma unroll
        for (int u = 0; u < 8; ++u) pf[u][qt] = pack_frag(sc[2 * u][qt], sc[2 * u + 1][qt]);
    }
#pragma unroll
    for (int h = 0; h < 2; ++h) {
        f32x4 acc_o[8][2];
#pragma unroll
        for (int d = 0; d < 8; ++d) { acc_o[d][0] = (f32x4){0.f, 0.f, 0.f, 0.f}; acc_o[d][1] = (f32x4){0.f, 0.f, 0.f, 0.f}; }
#pragma unroll
        for (int t = 0; t < 4; ++t) {
            __syncthreads();
#pragma unroll
            for (int q = 0; q < 2; ++q) { const int c = tid + q * 512; *(LAS u32x4*)(Vs + (c >> 3) * VSTR + (c & 7) * 8) = pV[q]; }
            __syncthreads();
            if (t < 3) XA_LOADV(h, t + 1); else if (h == 0) XA_LOADV(1, 0);
#pragma unroll
            for (int u = 0; u < 2; ++u)
#pragma unroll
                for (int d = 0; d < 8; ++d) { const bf16x8 vf = ld_frag_split(Vs + (d * 16 + i) * VSTR + u * 32 + quad * 4);
                    acc_o[d][0] = MFMA16(vf, pf[t * 2 + u][0], acc_o[d][0]); acc_o[d][1] = MFMA16(vf, pf[t * 2 + u][1], acc_o[d][1]); }
        }
#pragma unroll
        for (int qt = 0; qt < 2; ++qt) { bf16_t* op = O + (size_t)(wv * 32 + qt * 16 + i) * LDO + h * 128 + quad * 4;
#pragma unroll
            for (int d = 0; d < 8; ++d) { const f32x4 v = acc_o[d][qt] * linv[qt]; u32x2 p; p.x = cvt_pk_bf16(v[0], v[1]); p.y = cvt_pk_bf16(v[2], v[3]); *(u32x2*)(op + d * 16) = p; } }
    }
#undef XA_LOADK
#undef XA_LOADV
}

template <int NH>
__device__ __forceinline__ void ssd_item(LAS unsigned char* lds, const Args& a, int e, int b, int g, int hh, int lb, float* ss_g, bool commit) {
    static_assert(NH == 4, "layout below assumes 4 heads per item");
    constexpr int BSTR = 136, XSTR = 72;
    unsigned char* scr = a.ws + OFF_SCR;
    const bf16_t* bcc = (const bf16_t*)(scr + S_BCC); const bf16_t* xT = (const bf16_t*)(scr + S_XT); bf16_t* Z = (bf16_t*)(scr + S_Z);
    const float* cum = (const float*)(scr + S_CUM);
    const float* Dp = (const float*)a.in[21] + e * 16;
    LAS bf16_t* Bs = (LAS bf16_t*)lds; LAS bf16_t* Xs = Bs + 64 * BSTR; LAS float* aFs = (LAS float*)(Xs + NH * 64 * XSTR); LAS float* aBs = aFs + 64 * NH; LAS float* F2 = aBs + 64 * NH;
    const int tid = opaque_tid(), lane = tid & 63, wv = tid >> 6, i = lane & 15, quad = lane >> 4;
    LAS float* F2w = F2 + wv * (64 * NH);
    const int h0 = g * 8 + hh * NH, l0 = lb * 128, lg = l0 + wv * 16 + i, st_d = (l0 + wv * 16) >> 6;
    const size_t trow = (size_t)b * SEQ + lg;
    bf16x8 cf[4];
#pragma unroll
    for (int ks = 0; ks < 4; ++ks) cf[ks] = *(const bf16x8*)(bcc + trow * 512 + 256 + g * 128 + ks * 32 + quad * 8);
    float refF[NH], refB[NH];
    const float* crow = cum + trow * 64 + h0;
#pragma unroll
    for (int r = 0; r < NH; ++r) { const float c = crow[r], ee = crow[32 + r];
        refF[r] = __int_as_float(__builtin_amdgcn_readlane(__float_as_int(c), 0)); refB[r] = __int_as_float(__builtin_amdgcn_readlane(__float_as_int(ee), 15)); }
    f32x4 acc_o[NH][4]; float f1b[NH];
#pragma unroll
    for (int r = 0; r < NH; ++r)
#pragma unroll
        for (int pt = 0; pt < 4; ++pt) acc_o[r][pt] = (f32x4){0.f, 0.f, 0.f, 0.f};
#pragma unroll
    for (int r = 0; r < NH; ++r) f1b[r] = fexp2(refB[r] - crow[32 + r]);
    u32x4 pB[2], pX[4]; float pF = 0.f, pBk = 0.f;
    const bf16_t* bsrc = bcc + ((size_t)b * SEQ) * 512 + g * 128; const bf16_t* xsrc = xT + ((size_t)b * 1024 + h0 * 64) * SEQ;
#define SSD_LOAD(s0_) do { \
        _Pragma("unroll") for (int q = 0; q < 2; ++q) pB[q] = *(const u32x4*)((bsrc + (size_t)((s0_) + q * 32) * 512) + boff); \
        _Pragma("unroll") for (int q = 0; q < 4; ++q) pX[q] = *(const u32x4*)((xsrc + (size_t)q * 64 * SEQ + (s0_)) + xoff); \
        if (tid < 64 * NH) { const float* ap = cum + ((size_t)b * SEQ + (s0_) + (tid >> 2)) * 64 + h0 + (tid & 3); pF = ap[16]; pBk = ap[48]; } } while (0)
    const unsigned boff = (unsigned)((tid >> 4) * 512 + (tid & 15) * 8), xoff = (unsigned)((tid >> 3) * SEQ + (tid & 7) * 8);
    SSD_LOAD(0);
    for (int st = 0; st < SEQ / 64; ++st) {
        const int s0 = st * 64;
        __syncthreads();
#pragma unroll
        for (int q = 0; q < 2; ++q) { const int c = tid + q * 512, s = c >> 4, nc = (c & 15) * 8; *(LAS u32x4*)(Bs + s * BSTR + nc) = pB[q]; }
#pragma unroll
        for (int q = 0; q < 4; ++q) { const int c = tid + q * 512, row = c >> 3, kc = (c & 7) * 8; *(LAS u32x4*)(Xs + row * XSTR + kc) = pX[q]; }
        if (tid < 64 * NH) { aFs[tid] = pF; aBs[tid] = pBk; }
        __syncthreads();
        if (st + 1 < SEQ / 64) SSD_LOAD(s0 + 64);
        f32x4 cb[4];
#pragma unroll
        for (int kt = 0; kt < 4; ++kt) { cb[kt] = (f32x4){0.f, 0.f, 0.f, 0.f};
#pragma unroll
            for (int ks = 0; ks < 4; ++ks) cb[kt] = MFMA16(ld_frag16(Bs + (kt * 16 + i) * BSTR + ks * 32 + quad * 8), cf[ks], cb[kt]); }
        if (st == st_d) {
#pragma unroll
            for (int r = 0; r < NH; ++r) { const float f1 = fexp2(crow[r] - refF[r]);
#pragma unroll
                for (int pt = 0; pt < 4; ++pt) acc_o[r][pt] *= f1; }
#pragma unroll
            for (int r = 0; r < NH; ++r) {
                const float clr = crow[r], elr = crow[32 + r], ddr = Dp[h0 + r];
                f32x4 w[4];
#pragma unroll
                for (int kt = 0; kt < 4; ++kt)
#pragma unroll
                    for (int j = 0; j < 4; ++j) { const int sl = kt * 16 + quad * 4 + j, sg = s0 + sl; const float af = aFs[sl * NH + r], ab = aBs[sl * NH + r];
                        const float argf = clr - af, argb = ab - elr;
                        float v;
                        if (sg == lg) v = cb[kt][j] * (fexp2(argf) + fexp2(argb)) + ddr;
                        else v = cb[kt][j] * fexp2(sg < lg ? argf : argb);
                        w[kt][j] = v; }
                const bf16x8 p0 = pack_frag(w[0], w[1]), p1 = pack_frag(w[2], w[3]);
#pragma unroll
                for (int pt = 0; pt < 4; ++pt) {
                    acc_o[r][pt] = MFMA16(ld_frag_split(Xs + (r * 64 + pt * 16 + i) * XSTR + quad * 4), p0, acc_o[r][pt]);
                    acc_o[r][pt] = MFMA16(ld_frag_split(Xs + (r * 64 + pt * 16 + i) * XSTR + 32 + quad * 4), p1, acc_o[r][pt]); }
            }
        } else {
            const bool lower = st < st_d;
            { const f32x4 av = lower ? *(const LAS f32x4*)(aFs + lane * NH) : *(const LAS f32x4*)(aBs + lane * NH);
#pragma unroll
              for (int r = 0; r < NH; ++r) F2w[r * 64 + lane] = lower ? fexp2(refF[r] - av[r]) : fexp2(av[r] - refB[r]); }
            asm volatile("s_waitcnt lgkmcnt(0)" ::: "memory");
#define SSD_OFFDIAG(ACC, F1) do { _Pragma("unroll") for (int r = 0; r < NH; ++r) { bf16x8 p0, p1; \
                { const f32x4 w0 = cb[0] * *(const LAS f32x4*)(F2w + r * 64 + quad * 4) F1, w1 = cb[1] * *(const LAS f32x4*)(F2w + r * 64 + 16 + quad * 4) F1; p0 = pack_frag(w0, w1); } \
                { const f32x4 w2 = cb[2] * *(const LAS f32x4*)(F2w + r * 64 + 32 + quad * 4) F1, w3 = cb[3] * *(const LAS f32x4*)(F2w + r * 64 + 48 + quad * 4) F1; p1 = pack_frag(w2, w3); } \
                _Pragma("unroll") for (int pt = 0; pt < 4; ++pt) { \
                    ACC[r][pt] = MFMA16(ld_frag_split(Xs + (r * 64 + pt * 16 + i) * XSTR + quad * 4), p0, ACC[r][pt]); \
                    ACC[r][pt] = MFMA16(ld_frag_split(Xs + (r * 64 + pt * 16 + i) * XSTR + 32 + quad * 4), p1, ACC[r][pt]); } } } while (0)
            if (lower) SSD_OFFDIAG(acc_o, ); else SSD_OFFDIAG(acc_o, * f1b[r]);
#undef SSD_OFFDIAG
        }
    }
#undef SSD_LOAD
    float ss = 0.f;
#pragma unroll
    for (int r = 0; r < NH; ++r) {
#pragma unroll
        for (int pt = 0; pt < 4; ++pt) { const f32x4 yv = acc_o[r][pt];
            bf16_t* zp = Z + trow * 1024 + (h0 + r) * 64 + pt * 16 + quad * 4; const u32x2 zv = *(const u32x2*)zp;
            const float y0 = yv[0] * silu_f(bflo(zv.x)), y1 = yv[1] * silu_f(bfhi(zv.x)), y2 = yv[2] * silu_f(bflo(zv.y)), y3 = yv[3] * silu_f(bfhi(zv.y));
            ss += y0 * y0 + y1 * y1 + y2 * y2 + y3 * y3; u32x2 o; o.x = cvt_pk_bf16(y0, y1); o.y = cvt_pk_bf16(y2, y3); if (commit) *(u32x2*)zp = o; } }
    ss += shfl_xor_f(ss, 16); ss += shfl_xor_f(ss, 32);
    if (quad == 0 && commit) { float* gp = ss_g + trow * 16 + g * 2 + hh; gp[0] = ss; gp[4] = 0.f; gp[8] = 0.f; gp[12] = 0.f; }
}

__device__ __forceinline__ void ssd_item2(LAS unsigned char* lds, const Args& a, int e, int b, int g, int hq, int lb, float* ss_g, bool commit) {
    constexpr int NH = 2, BSTR = 136, XSTR = 72;
    unsigned char* scr = a.ws + OFF_SCR;
    const bf16_t* bcc = (const bf16_t*)(scr + S_BCC); const bf16_t* xT = (const bf16_t*)(scr + S_XT); bf16_t* Z = (bf16_t*)(scr + S_Z);
    const float* cum = (const float*)(scr + S_CUM);
    const float* Dp = (const float*)a.in[21] + e * 16;
    LAS bf16_t* Bs = (LAS bf16_t*)lds; LAS bf16_t* Xs = Bs + 64 * BSTR; LAS float* aFs = (LAS float*)(Xs + NH * 64 * XSTR); LAS float* aBs = aFs + 64 * NH; LAS float* F2 = aBs + 64 * NH;
    const int tid = opaque_tid(), lane = tid & 63, wv = tid >> 6, i = lane & 15, quad = lane >> 4;
    LAS float* F2w = F2 + wv * (64 * NH);
    const int h0 = g * 8 + hq * NH, l0 = lb * 256 + wv * 32, st_d = l0 >> 6;
    const size_t trow0 = (size_t)b * SEQ + l0 + i;
    bf16x8 cf[2][4];
#pragma unroll
    for (int qt = 0; qt < 2; ++qt)
#pragma unroll
        for (int ks = 0; ks < 4; ++ks) cf[qt][ks] = *(const bf16x8*)(bcc + (trow0 + 16 * qt) * 512 + 256 + g * 128 + ks * 32 + quad * 8);
    const float* crow = cum + trow0 * 64 + h0;
    float refF[NH], refB[NH], f1b[2][NH];
#pragma unroll
    for (int r = 0; r < NH; ++r) { const float c = crow[r], ee = crow[16 * 64 + 32 + r];
        refF[r] = __int_as_float(__builtin_amdgcn_readlane(__float_as_int(c), 0)); refB[r] = __int_as_float(__builtin_amdgcn_readlane(__float_as_int(ee), 15));
        f1b[0][r] = fexp2(refB[r] - crow[32 + r]); f1b[1][r] = fexp2(refB[r] - ee); }
    f32x4 acc_o[NH][4][2];
#pragma unroll
    for (int r = 0; r < NH; ++r)
#pragma unroll
        for (int pt = 0; pt < 4; ++pt) { acc_o[r][pt][0] = (f32x4){0.f, 0.f, 0.f, 0.f}; acc_o[r][pt][1] = (f32x4){0.f, 0.f, 0.f, 0.f}; }
    u32x4 pB[2], pX[2]; float pF = 0.f, pBk = 0.f;
    const bf16_t* bsrc = bcc + ((size_t)b * SEQ) * 512 + g * 128; const bf16_t* xsrc = xT + ((size_t)b * 1024 + h0 * 64) * SEQ;
    const unsigned boff = (unsigned)((tid >> 4) * 512 + (tid & 15) * 8), xoff = (unsigned)((tid >> 3) * SEQ + (tid & 7) * 8);
#define SSD_LOAD(s0_) do { \
        _Pragma("unroll") for (int q = 0; q < 2; ++q) pB[q] = *(const u32x4*)((bsrc + (size_t)((s0_) + q * 32) * 512) + boff); \
        _Pragma("unroll") for (int q = 0; q < 2; ++q) pX[q] = *(const u32x4*)((xsrc + (size_t)q * 64 * SEQ + (s0_)) + xoff); \
        if (tid < 64 * NH) { const float* ap = cum + ((size_t)b * SEQ + (s0_) + (tid >> 1)) * 64 + h0 + (tid & 1); pF = ap[16]; pBk = ap[48]; } } while (0)
    SSD_LOAD(0);
    for (int st = 0; st < SEQ / 64; ++st) {
        const int s0 = st * 64;
        __syncthreads();
#pragma unroll
        for (int q = 0; q < 2; ++q) { const int c = tid + q * 512, s = c >> 4, nc = (c & 15) * 8; *(LAS u32x4*)(Bs + s * BSTR + nc) = pB[q]; }
#pragma unroll
        for (int q = 0; q < 2; ++q) { const int c = tid + q * 512, row = c >> 3, kc = (c & 7) * 8; *(LAS u32x4*)(Xs + row * XSTR + kc) = pX[q]; }
        if (tid < 64 * NH) { aFs[tid] = pF; aBs[tid] = pBk; }
        __syncthreads();
        if (st + 1 < SEQ / 64) SSD_LOAD(s0 + 64);
        const bool diag = (st == st_d), lower = st < st_d; bool live0 = true, live1 = true;
        if (diag) {
#pragma unroll
            for (int r = 0; r < NH; ++r)
#pragma unroll
                for (int qt = 0; qt < 2; ++qt) { const float f1 = fexp2(crow[qt * 16 * 64 + r] - refF[r]);
#pragma unroll
                    for (int pt = 0; pt < 4; ++pt) acc_o[r][pt][qt] *= f1; }
        } else {
            const float av0 = lower ? aFs[lane * NH] : aBs[lane * NH], av1 = lower ? aFs[lane * NH + 1] : aBs[lane * NH + 1];
            const float f20 = lower ? fexp2(refF[0] - av0) : fexp2(av0 - refB[0]), f21 = lower ? fexp2(refF[1] - av1) : fexp2(av1 - refB[1]);
            F2w[lane] = f20; F2w[64 + lane] = f21;
            live0 = __builtin_amdgcn_ballot_w64(f20 != 0.f) != 0ull; live1 = __builtin_amdgcn_ballot_w64(f21 != 0.f) != 0ull;
            asm volatile("s_waitcnt lgkmcnt(0)" ::: "memory");
        }
        if (live0 || live1) {
#pragma unroll
        for (int u = 0; u < 2; ++u) {
            f32x4 cb[2][2];
#pragma unroll
            for (int kk = 0; kk < 2; ++kk) { cb[kk][0] = (f32x4){0.f, 0.f, 0.f, 0.f}; cb[kk][1] = (f32x4){0.f, 0.f, 0.f, 0.f};
#pragma unroll
                for (int ks = 0; ks < 4; ++ks) { const bf16x8 bf = ld_frag16(Bs + ((2 * u + kk) * 16 + i) * BSTR + ks * 32 + quad * 8);
                    cb[kk][0] = MFMA16(bf, cf[0][ks], cb[kk][0]); cb[kk][1] = MFMA16(bf, cf[1][ks], cb[kk][1]); } }
#pragma unroll
            for (int r = 0; r < NH; ++r) {
                if (!(r == 0 ? live0 : live1)) continue;
                bf16x8 p[2];
                if (diag) {
                    const float ddr = Dp[h0 + r];
#pragma unroll
                    for (int qt = 0; qt < 2; ++qt) { const float clr = crow[qt * 16 * 64 + r], elr = crow[qt * 16 * 64 + 32 + r]; const int lg = l0 + 16 * qt + i; f32x4 w[2];
#pragma unroll
                        for (int kk = 0; kk < 2; ++kk)
#pragma unroll
                            for (int j = 0; j < 4; ++j) { const int sl = (2 * u + kk) * 16 + quad * 4 + j, sg = s0 + sl; const float af = aFs[sl * NH + r], ab = aBs[sl * NH + r];
                                const float argf = clr - af, argb = ab - elr; float v;
                                if (sg == lg) v = cb[kk][qt][j] * (fexp2(argf) + fexp2(argb)) + ddr;
                                else v = cb[kk][qt][j] * fexp2(sg < lg ? argf : argb);
                                w[kk][j] = v; }
                        p[qt] = pack_frag(w[0], w[1]); }
                } else {
                    const f32x4 fa = *(const LAS f32x4*)(F2w + r * 64 + u * 32 + quad * 4), fb = *(const LAS f32x4*)(F2w + r * 64 + u * 32 + 16 + quad * 4);
#pragma unroll
                    for (int qt = 0; qt < 2; ++qt) { const float fs = lower ? 1.0f : f1b[qt][r]; p[qt] = pack_frag(cb[0][qt] * fa * fs, cb[1][qt] * fb * fs); }
                }
#pragma unroll
                for (int pt = 0; pt < 4; ++pt) { const bf16x8 xf = ld_frag_split(Xs + (r * 64 + pt * 16 + i) * XSTR + u * 32 + quad * 4);
                    acc_o[r][pt][0] = MFMA16(xf, p[0], acc_o[r][pt][0]); acc_o[r][pt][1] = MFMA16(xf, p[1], acc_o[r][pt][1]); }
            }
        }
        }
    }
#undef SSD_LOAD
#pragma unroll
    for (int qt = 0; qt < 2; ++qt) { float ss = 0.f; const size_t trow = trow0 + 16 * qt;
#pragma unroll
        for (int r = 0; r < NH; ++r)
#pragma unroll
            for (int pt = 0; pt < 4; ++pt) { const f32x4 yv = acc_o[r][pt][qt];
                bf16_t* zp = Z + trow * 1536 + (h0 + r) * 64 + pt * 16 + quad * 4; const u32x2 zv = *(const u32x2*)zp;
                const float y0 = yv[0] * silu_f(bflo(zv.x)), y1 = yv[1] * silu_f(bfhi(zv.x)), y2 = yv[2] * silu_f(bflo(zv.y)), y3 = yv[3] * silu_f(bfhi(zv.y));
                ss += y0 * y0 + y1 * y1 + y2 * y2 + y3 * y3; u32x2 o; o.x = cvt_pk_bf16(y0, y1); o.y = cvt_pk_bf16(y2, y3); if (commit) *(u32x2*)zp = o; }
        ss += shfl_xor_f(ss, 16); ss += shfl_xor_f(ss, 32);
        if (quad == 0 && commit) { float* gp = ss_g + trow * 16 + g * 4 + hq; gp[0] = ss; gp[8] = 0.f; } }
}

__device__ void fnet_norm_T(const Args& a, int l, const float* rss, LAS unsigned char* lds) {
    const float* h = a.out; const float* w = (const float*)a.in[8] + l * DM; bf16_t* uT = (bf16_t*)(a.ws + OFF_SCR + S_UT);
    LAS bf16_t* tl = (LAS bf16_t*)lds; const int tid = opaque_tid();
    for (int trip = 0; ; ++trip) { const int it = xcd_item(trip, NB * 32 * 4); if (it < 0) break;
        const int b = it >> 7, st = (it >> 2) & 31, ct = it & 3, s0 = st * 64, c0 = ct * 256;
        { const int s = tid >> 3, cv = tid & 7; const size_t row = (size_t)b * SEQ + s0 + s;
          const float rs = rstd_of(ss_sum(rss, row, 16), 1.0f / DM);
          f32x4 v0[4], v1[4];
#pragma unroll
          for (int j = 0; j < 4; ++j) { const int ch = c0 + 64 * j + 8 * cv; v0[j] = *(const f32x4*)(h + row * DM + ch); v1[j] = *(const f32x4*)(h + row * DM + ch + 4); }
#pragma unroll
          for (int j = 0; j < 4; ++j) { const int ch = c0 + 64 * j + 8 * cv; const f32x4 w0 = *(const f32x4*)(w + ch), w1 = *(const f32x4*)(w + ch + 4);
              const f32x4 r0 = v0[j] * w0 * rs, r1 = v1[j] * w1 * rs;
              const unsigned p0 = cvt_pk_bf16(r0[0], r0[1]), p1 = cvt_pk_bf16(r0[2], r0[3]), p2 = cvt_pk_bf16(r1[0], r1[1]), p3 = cvt_pk_bf16(r1[2], r1[3]);
              LAS bf16_t* tp = tl + (64 * j + 8 * cv) * 72 + s;
              tp[0] = (bf16_t)(p0 & 0xffff); tp[72] = (bf16_t)(p0 >> 16); tp[144] = (bf16_t)(p1 & 0xffff); tp[216] = (bf16_t)(p1 >> 16);
              tp[288] = (bf16_t)(p2 & 0xffff); tp[360] = (bf16_t)(p2 >> 16); tp[432] = (bf16_t)(p3 & 0xffff); tp[504] = (bf16_t)(p3 >> 16); } }
        __syncthreads();
        { const int sv = tid & 7;
#pragma unroll
          for (int j = 0; j < 4; ++j) { const int ch = (tid >> 3) + 64 * j; const u32x4 v = *(const LAS u32x4*)(tl + ch * 72 + 8 * sv);
              *(u32x4*)(uT + ((size_t)b * 1024 + c0 + ch) * SEQ + s0 + 8 * sv) = v; } }
        __syncthreads();
    }
}
__device__ void final_norm(const Args& a, const float* rss) {
    const float* w = (const float*)a.in[4]; const int tid = opaque_tid(); const int lane = tid & 63, wv = tid >> 6;
    for (int rl = (int)(blockIdx.x >> 3) * 8 + wv; rl < T_TOK / 8; rl += (int)(gridDim.x >> 3) * 8) { const int r = (int)(blockIdx.x & 7) * (T_TOK / 8) + rl;
        const float rs = rstd_of(ss_sum(rss, (size_t)r, 16), 1.0f / DM); float* p = a.out + (size_t)r * DM + lane * 4;
#pragma unroll
        for (int k = 0; k < 4; ++k) { const f32x4 v = *(const f32x4*)(p + k * 256), wv4 = *(const f32x4*)(w + lane * 4 + k * 256); *(f32x4*)(p + k * 256) = v * wv4 * rs; }
    }
}


#define XB_TMO      128
#define XB_XCNT(j)  (256  + 64 * (j))
#define XB_XSUB(j)  (1280 + 64 * (j))
#define XB_XGEN(j)  (2304 + 64 * (j))
#define XB_TOP      3328
#define XB_TOPGEN   3392
#define XCD_BAR_WORDS 3456
#define XB_SPIN_CAP (1u << 18)
__device__ __forceinline__ unsigned xb_ld(unsigned* p)              { return __hip_atomic_load(p, __ATOMIC_RELAXED, __HIP_MEMORY_SCOPE_AGENT); }
__device__ __forceinline__ unsigned xb_add(unsigned* p, unsigned v) { return __hip_atomic_fetch_add(p, v, __ATOMIC_RELAXED, __HIP_MEMORY_SCOPE_AGENT); }
__device__ __forceinline__ unsigned xb_xcc_id() { return (unsigned)__builtin_amdgcn_s_getreg((3 << 11) | 20) & 0xFu; }
#define XB_SPIN(cond, bar) do { unsigned _sp = 0; while (cond) { __builtin_amdgcn_s_sleep(1); \
    if ((++_sp & 255u) == 0u) { if (xb_ld(&(bar)[XB_TMO])) break; if (_sp > XB_SPIN_CAP) { atomicAdd(&(bar)[XB_TMO], 1u); break; } } } } while (0)
struct XcdBarrier { unsigned* bar; unsigned x; volatile LAS unsigned* st; };
__device__ __forceinline__ XcdBarrier xcd_barrier_post(unsigned* bar, volatile LAS unsigned* st) {
    XcdBarrier b; b.bar = bar; b.x = xb_xcc_id(); b.st = st;
    if (threadIdx.x == 0) (void)xb_add(&bar[XB_XCNT(b.x)], 1u);
    return b;
}
__device__ __forceinline__ void xcd_barrier_complete(unsigned* bar, unsigned x, unsigned& nloc, unsigned& nx) {
    const unsigned G = gridDim.x * gridDim.y * gridDim.z;
    unsigned sum, cnt, mine, sp = 0u;
    for (;;) {
        sum = 0u; cnt = 0u; mine = 0u;
#pragma unroll
        for (unsigned j = 0; j < 16; ++j) { const unsigned c = xb_ld(&bar[XB_XCNT(j)]); sum += c; cnt += (c > 0u) ? 1u : 0u; mine = (j == x) ? c : mine; }
        if (sum == G) break;
        __builtin_amdgcn_s_sleep(1);
        if ((++sp & 255u) == 0u) { if (xb_ld(&bar[XB_TMO])) break; if (sp > XB_SPIN_CAP) { atomicAdd(&bar[XB_TMO], 1u); break; } }
    }
    nloc = mine > 0u ? mine : 1u; nx = cnt > 0u ? cnt : 1u;
}
__device__ __forceinline__ void xcd_barrier(const XcdBarrier& b) {
    asm volatile("s_waitcnt vmcnt(0)" ::: "memory");
    __syncthreads();
    if (threadIdx.x == 0) {
        unsigned* bar = b.bar;
        __builtin_amdgcn_s_waitcnt(0);
        unsigned nloc = b.st[0], nx = b.st[1];
        if (nloc == 0u) { xcd_barrier_complete(bar, b.x, nloc, nx); b.st[0] = nloc; b.st[1] = nx; }
        const unsigned old = xb_add(&bar[XB_XSUB(b.x)], 1u);
        const unsigned gen = old / nloc;
        if (old + 1u == (gen + 1u) * nloc) {
            __builtin_amdgcn_fence(__ATOMIC_RELEASE, "agent");
            asm volatile("s_waitcnt vmcnt(0)" ::: "memory");
            const unsigned og = xb_add(&bar[XB_TOP], 1u);
            const unsigned tg = og / nx;
            if (og + 1u == (tg + 1u) * nx) xb_add(&bar[XB_TOPGEN], 1u);
            else XB_SPIN(xb_ld(&bar[XB_TOPGEN]) == tg, bar);
            __builtin_amdgcn_fence(__ATOMIC_ACQUIRE, "agent");
            xb_add(&bar[XB_XGEN(b.x)], 1u);
            asm volatile("s_waitcnt vmcnt(0)" ::: "memory");
        } else {
            XB_SPIN(xb_ld(&bar[XB_XGEN(b.x)]) == gen, bar);
            __builtin_amdgcn_fence(__ATOMIC_ACQUIRE, "agent");
            asm volatile("s_waitcnt vmcnt(0)" ::: "memory");
        }
    }
    __syncthreads();
}

enum { PT_INIT = 0, PT_CONVERT, PT_FFN1A, PT_FFN1B, PT_E1, PT_E2, PT_E3, PT_E4, PT_E5, PT_O1, PT_O2, PT_O3, PT_X1, PT_X2, PT_X3, PT_FFN2A, PT_FFN2B, PT_FINAL };
enum { EK_NONE = -1, EK_SWIGLU = 0, EK_RESID, EK_STORE, EK_STORE_ROPE, EK_STORE_DFT, EK_WIN };
#ifndef DUP_MASK
#define DUP_MASK 0
#endif
#define PH(t, l) {t, l},
#define PHD(t, l) {t, l}, {(unsigned char)(((DUP_MASK >> (t)) & 1) ? (t) : 99), (unsigned char)((l) | 128)},
#define LAYER_EVEN(l) PHD(PT_FFN1A, l) PHD(PT_FFN1B, l) PHD(PT_E1, l) PHD(PT_E2, l) PHD(PT_E3, l) PHD(PT_E4, l) PHD(PT_E5, l) PHD(PT_X1, l) PHD(PT_X2, l) PHD(PT_X3, l) PHD(PT_FFN2A, l) PHD(PT_FFN2B, l)
#define LAYER_ODD(l) PHD(PT_FFN1A, l) PHD(PT_FFN1B, l) PHD(PT_O1, l) PHD(PT_O2, l) PHD(PT_O3, l) PHD(PT_X1, l) PHD(PT_X2, l) PHD(PT_X3, l) PHD(PT_FFN2A, l) PHD(PT_FFN2B, l)
#if DUP_MASK
__constant__ unsigned char PROG[][2] = { PH(PT_INIT, 0) LAYER_EVEN(0) PHD(PT_CONVERT, 1) LAYER_ODD(1) PHD(PT_CONVERT, 2) LAYER_EVEN(2) PHD(PT_CONVERT, 3) LAYER_ODD(3) PH(PT_FINAL, 0) };
#else
#undef PHD
#define PHD(t, l) {t, l},
__constant__ unsigned char PROG[][2] = { PH(PT_INIT, 0) LAYER_EVEN(0) PHD(PT_CONVERT, 1) LAYER_ODD(1) PHD(PT_CONVERT, 2) LAYER_EVEN(2) PHD(PT_CONVERT, 3) LAYER_ODD(3) PH(PT_FINAL, 0) };
#endif
constexpr int N_PHASES = (int)(sizeof(PROG) / 2);

struct EP { bf16_t* out; long ldc; const float* hin; bf16_t* hb; float* ss_out; const float* rss; int rss_w; float rs_inv; const float* css; int css_w; float cs_inv; long zoff; float alpha; };

__device__ __forceinline__ int build_job(const Args& a, int type, int l, int j, Gemm& g, EP& ep) {
    unsigned char* ws = a.ws; unsigned char* scr = ws + OFF_SCR;
    bf16_t* wb = (bf16_t*)(ws + OFF_WB); bf16_t* hb = (bf16_t*)(ws + OFF_HB);
    float* rowss = (float*)(ws + OFF_ROWSS); float* memss = (float*)(ws + OFF_MEMSS);
    float* h0 = rowss + RS_H0; float* h1 = rowss + RS_H1;
    float* ss_cq = rowss + RS_CQ; float* ss_ckv = rowss + RS_CKV; float* ss_g = rowss + RS_G;
    ep.out = nullptr; ep.ldc = 0; ep.hin = a.out; ep.hb = nullptr; ep.ss_out = nullptr; ep.rss = nullptr; ep.rss_w = 16; ep.rs_inv = 0.f; ep.css = nullptr; ep.css_w = 1; ep.cs_inv = 0.f; ep.zoff = 0; ep.alpha = 1.0f;
    switch (type) {
    case PT_FFN1A: case PT_FFN2A:
        if (j == 0) { g = mk_gemm(hb, DM, wb + (type == PT_FFN1A ? W_GU1 : W_GU2), DM, DM, 128, 22); ep.out = (bf16_t*)(scr + S_ACT); ep.rss = (type == PT_FFN1A ? h0 : h1); return EK_SWIGLU; }
        if (j == 1 && type == PT_FFN1A && (l & 1)) {
            g = mk_gemm(wb + W_FT, DM, (const bf16_t*)(ws + OFF_TCH), 256, 256, 4, 1); g.nZ = 8; g.zd = 4; g.sA1 = 0; g.sA2 = 256; g.sB1 = 65536; g.sB2 = 0;
            ep.out = wb + W_FOLD; ep.ldc = 2048; ep.zoff = 256; return EK_STORE; }
        return EK_NONE;
    case PT_FFN1B: case PT_FFN2B:
        if (j == 0) { g = mk_gemm((const bf16_t*)(scr + S_ACT), DFF, wb + (type == PT_FFN1B ? W_DN1 : W_DN2), DFF, DFF, 128, 4);
            ep.hin = (type == PT_FFN1B && l == 0) ? (const float*)a.in[0] : a.out; ep.hb = (type == PT_FFN2B && l == 3) ? nullptr : hb;     ep.ss_out = (type == PT_FFN1B ? h1 : h0); ep.alpha = 0.5f; return EK_RESID; }
        return EK_NONE;
    case PT_E1:
        if (j == 0) { g = mk_gemm(hb, DM, wb + W_IN, DM, DM, 128, 14); ep.rss = h1; ep.ss_out = ss_cq; ep.css = ss_ckv; return EK_WIN; }
        return EK_NONE;
    case PT_E3:
        if (j == 0) { g = mk_gemm((const bf16_t*)(scr + S_CQ), 512, wb + W_UQ, 512, 512, 128, 3); ep.out = (bf16_t*)(scr + S_QB); ep.ldc = 768; ep.rss = ss_cq; ep.rss_w = 8; ep.rs_inv = 1.0f / 512; return EK_STORE_ROPE; }
        if (j == 1) { g = mk_gemm((const bf16_t*)(scr + S_CKV), 256, wb + W_KN, 256, 256, 128, 2); ep.out = (bf16_t*)(scr + S_KN); ep.ldc = 512; ep.rss = ss_ckv; ep.rss_w = 4; ep.rs_inv = 1.0f / 256; return EK_STORE; }
        if (j == 2) { g = mk_gemm(wb + W_VV, 256, (const bf16_t*)(scr + S_CKV), 256, 256, 2, 128); ep.out = hb; ep.ldc = T_TOK; ep.css = ss_ckv; ep.css_w = 4; ep.cs_inv = 1.0f / 256; return EK_STORE; }
        return EK_NONE;
    case PT_E5:
        if (j == 0) { g = mk_gemm((const bf16_t*)(scr + S_Z), 1536, wb + W_OY, 1536, 1536, 128, 4); ep.rss = ss_g; ep.rss_w = 4; ep.rs_inv = 1.0f / 1024; ep.hb = hb; ep.ss_out = h0; return EK_RESID; }
        return EK_NONE;
    case PT_O2:
        if (j == 0) { g = mk_gemm((const bf16_t*)(ws + OFF_FSEQ), 2048, (const bf16_t*)(scr + S_UT), 2048, 2048, 8, 64); ep.out = (bf16_t*)(scr + S_YCS); ep.ldc = 2048; return EK_STORE_DFT; }
        return EK_NONE;
    case PT_O3:
        if (j == 0) { g = mk_gemm((const bf16_t*)(scr + S_YCS), 2048, wb + W_FOLD, 2048, 2048, 128, 4); ep.hb = hb; ep.ss_out = h0; return EK_RESID; }
        return EK_NONE;
    case PT_X1:
        if (j == 0) { g = mk_gemm(hb, DM, wb + W_Q, DM, DM, 128, 4); ep.out = (bf16_t*)(scr + S_XQ); ep.ldc = 1024; ep.rss = h0; ep.rs_inv = 1.0f / DM; return EK_STORE; }
        if (j == 1) { g = mk_gemm((const bf16_t*)(ws + OFF_MEMB), DM, wb + W_K, DM, DM, 16, 4); g.rot = 128; ep.out = (bf16_t*)(ws + OFF_KMEM); ep.ldc = 1024; ep.rss = memss; ep.rss_w = 1; ep.rs_inv = 1.0f / DM; return EK_STORE; }
        if (j == 2) { g = mk_gemm(wb + W_V, DM, (const bf16_t*)(ws + OFF_MEMB), DM, DM, 4, 16); g.rot = 64; ep.out = (bf16_t*)(ws + OFF_VTM); ep.ldc = TMEM; ep.css = memss; ep.cs_inv = 1.0f / DM; return EK_STORE; }
        return EK_NONE;
    case PT_X3:
        if (j == 0) { g = mk_gemm((const bf16_t*)(scr + S_XO), DM, wb + W_O, DM, DM, 128, 4); ep.hb = hb; ep.ss_out = h1; return EK_RESID; }
        return EK_NONE;
    default: return EK_NONE;
    }
}

__global__ void __launch_bounds__(512, 2) mk_fwd(Args a) {
    extern __shared__ __attribute__((aligned(16))) unsigned char shm[];
    LAS unsigned char* lds = (LAS unsigned char*)shm;
    unsigned char* ws = a.ws; unsigned char* scr = ws + OFF_SCR;
    const int* pos = (const int*)a.in[2];
    LAS unsigned* xst = (LAS unsigned*)(lds + LDS_XST);
    if (threadIdx.x == 0) { xst[0] = 0u; xst[1] = 0u; }
    __syncthreads();
    const XcdBarrier xb = xcd_barrier_post((unsigned*)(ws + OFF_BAR), (volatile LAS unsigned*)xst);
    for (int ph = a.ph_lo; ph < a.ph_hi && ph < N_PHASES; ++ph) {
        int type = PROG[ph][0]; const int l = PROG[ph][1] & 3, e = l >> 1; const bool dup = (PROG[ph][1] & 128) != 0;
#ifdef DBG_LAYERS
        if (l >= DBG_LAYERS && type != PT_FINAL) type = 99;
#endif
#ifdef DBG_SKIP_MIX
        if (type >= PT_E1 && type <= PT_O3) type = 99;
#endif
#ifdef DBG_SKIP_XA
        if (type >= PT_X1 && type <= PT_X3) type = 99;
#endif
        if (type == 99) continue;
        float* rowss = (float*)(ws + OFF_ROWSS);
        for (int j = 0; j < 3; ++j) {
            Gemm g; EP ep; const int ek = build_job(a, type, l, j, g, ep);
            if (ek == EK_NONE) break;
            if (dup) { ep.alpha = 0.f; ep.hin = a.out; }
            LAS float* rsc = (LAS float*)(lds + LDS_RSC) + threadIdx.x * 9; rsc[0] = __int_as_float(-1);
            switch (ek) {
            case EK_SWIGLU: { EpiSwiglu E; E.rsc = rsc; E.act = ep.out; E.rss = ep.rss; E.rss_w = ep.rss_w; gemm_phase(lds, g, E); } break;
            case EK_RESID: { EpiResid E; E.rsc = rsc; E.hin = ep.hin; E.hout = a.out; E.hb = ep.hb; E.ss_out = ep.ss_out; E.rss = ep.rss; E.rss_w = ep.rss_w; E.rss_inv_dim = ep.rs_inv; E.alpha = ep.alpha; gemm_phase(lds, g, E); } break;
            case EK_STORE: { EpiStore<0, false> E; E.rsc = rsc; E.out = ep.out; E.ldc = ep.ldc; E.rss = ep.rss; E.rss_w = ep.rss_w; E.rs_inv_dim = ep.rs_inv; E.css = ep.css; E.css_w = ep.css_w; E.cs_inv_dim = ep.cs_inv; E.zoff = ep.zoff; E.pos = nullptr; gemm_phase(lds, g, E); } break;
            case EK_STORE_ROPE: { EpiStore<0, true> E; E.rsc = rsc; E.out = ep.out; E.ldc = ep.ldc; E.rss = ep.rss; E.rss_w = ep.rss_w; E.rs_inv_dim = ep.rs_inv; E.css = nullptr; E.css_w = 1; E.cs_inv_dim = 0.f; E.zoff = 0; E.pos = pos; gemm_phase(lds, g, E); } break;
            case EK_STORE_DFT: { EpiStore<1, false> E; E.rsc = rsc; E.out = ep.out; E.ldc = ep.ldc; E.rss = nullptr; E.rss_w = 1; E.css_w = 1; E.rs_inv_dim = 0.f; E.css = nullptr; E.cs_inv_dim = 0.f; E.zoff = 0; E.pos = nullptr; gemm_phase(lds, g, E); } break;
            default: { EpiWin E; E.rsc = rsc; E.scr = scr; E.rss = ep.rss; E.rss_w = ep.rss_w; E.ss_cq = ep.ss_out; E.ss_ckv = (float*)ep.css; E.pos = pos; gemm_phase(lds, g, E); } break;
            }
        }
        switch (type) {
        case PT_INIT:
            rows_to_bf16((const float*)a.in[0], (bf16_t*)(ws + OFF_HB), rowss + RS_H0, T_TOK, 16);
            rows_to_bf16((const float*)a.in[1], (bf16_t*)(ws + OFF_MEMB), (float*)(ws + OFF_MEMSS), TMEM, 16);
            gen_tables(a);
            convert_layer(a, 0, (LAS float*)lds);
            break;
        case PT_CONVERT: convert_layer(a, l, (LAS float*)lds); break;
        case PT_E2: conv_phase(a, e, lds); break;
        case PT_E3:
            for (int trip = 0; ; ++trip) { const int it = xcd_item(trip, NB * 2 * 4 * 8); if (it < 0) break; const int b = it >> 6, g = (it >> 5) & 1, hq = (it >> 3) & 3, lb = it & 7;
                ssd_item2(lds, a, e, b, g, hq, lb, rowss + RS_G, !dup); }
            break;
        case PT_E4:
            for (int trip = 0; ; ++trip) { const int it = xcd_item(trip, NB * 8 * 8); if (it < 0) break; const int b = it >> 6, hd = (it >> 3) & 7, qb = it & 7; const size_t r0 = (size_t)b * SEQ;
                attn_item<96, 64, 64, 2, 2>(lds, (const bf16_t*)(scr + S_QB) + (r0 + qb * 256) * 768 + hd * 96, 768,
                    (const bf16_t*)(scr + S_KN) + r0 * 512 + hd * 64, 512, (const bf16_t*)(scr + S_KROPE) + r0 * 32, 32,
                    (const bf16_t*)(ws + OFF_HB) + (size_t)(hd * 64) * T_TOK + r0, T_TOK, SEQ, (bf16_t*)(scr + S_Z) + (r0 + qb * 256) * 1536 + 1024 + hd * 64, 1536, rowss + RS_G + (r0 + qb * 256) * 16); }
            break;
        case PT_O1: fnet_norm_T(a, l, rowss + RS_H1, lds); break;
        case PT_X2:
            for (int trip = 0; ; ++trip) { const int it = xcd_item(trip, NB * 4 * 8); if (it < 0) break; const int b = it >> 5, hd = (it >> 3) & 3, qb = it & 7; const size_t r0 = (size_t)b * SEQ + qb * 256;
                xa_item(lds, (const bf16_t*)(scr + S_XQ) + r0 * 1024 + hd * 256, (const bf16_t*)(ws + OFF_KMEM) + (size_t)(b * NMEM) * 1024 + hd * 256,
                    (const bf16_t*)(ws + OFF_VTM) + (size_t)(hd * 256) * TMEM + b * NMEM, (bf16_t*)(scr + S_XO) + r0 * 1024 + hd * 256); }
            break;
        case PT_FINAL: final_norm(a, rowss + RS_H0); break;
        default: break;
        }
        if (ph + 1 < a.ph_hi && ph + 1 < N_PHASES) {
            if (ph == a.ph_lo) {
                asm volatile("s_waitcnt vmcnt(0) lgkmcnt(0)" ::: "memory");
                __syncthreads();
                if (threadIdx.x < 64) { __builtin_amdgcn_fence(__ATOMIC_RELEASE, "agent"); asm volatile("s_waitcnt vmcnt(0) lgkmcnt(0)" ::: "memory"); }
                cg::this_grid().sync();
                __builtin_amdgcn_fence(__ATOMIC_ACQUIRE, "agent");
                asm volatile("s_waitcnt vmcnt(0) lgkmcnt(0)" ::: "memory");
            } else xcd_barrier(xb);
        }
    }
}

extern "C" void kernel_launch(void* const* d_in, const int* in_sizes, int n_in, void* d_out, int out_size, void* d_ws, size_t ws_size, hipStream_t stream) {
    static int grid = 0;
    if (grid == 0) {
        if (n_in != 29 || ws_size < WS_NEED) { fprintf(stderr, "kernel_launch: need 29 inputs and %zu bytes of workspace; got %d, %zu\n", (size_t)WS_NEED, n_in, ws_size); grid = -1; return; }
        int dev = 0, cus = 0, per_cu = 0;
        hipGetDevice(&dev); hipDeviceGetAttribute(&cus, hipDeviceAttributeMultiprocessorCount, dev);
        if (hipFuncSetAttribute((const void*)mk_fwd, hipFuncAttributeMaxDynamicSharedMemorySize, LDS_BYTES) != hipSuccess) { fprintf(stderr, "kernel_launch: hipFuncSetAttribute failed\n"); grid = -1; return; }
        if (hipOccupancyMaxActiveBlocksPerMultiprocessor(&per_cu, (const void*)mk_fwd, 512, LDS_BYTES) != hipSuccess || per_cu < 1) { fprintf(stderr, "kernel_launch: occupancy query says %d\n", per_cu); per_cu = 1; }
        (void)hipGetLastError();
        grid = cus;
    }
    if (grid < 0) return;
    Args a{};
    for (int i = 0; i < 29; ++i) a.in[i] = d_in[i];
    a.out = (float*)d_out; a.ws = (unsigned char*)d_ws; a.ph_lo = 0; a.ph_hi = 1000;
    (void)hipMemsetAsync((char*)d_ws + OFF_BAR, 0, 16384, stream);
    void* args[] = {&a};
    hipError_t e = hipLaunchCooperativeKernel((const void*)mk_fwd, dim3(grid), dim3(512), args, LDS_BYTES, stream);
    if (e != hipSuccess) fprintf(stderr, "cooperative launch failed: %s (grid %d)\n", hipGetErrorString(e), grid);
}
```

```cpp
#include <hip/hip_runtime.h>
#include <hip/hip_cooperative_groups.h>
#include <cstdio>
namespace cg = cooperative_groups;

#define LAS __attribute__((address_space(3)))
typedef unsigned short bf16_t;
typedef short bf16x8 __attribute__((ext_vector_type(8)));
typedef short bf16x4 __attribute__((ext_vector_type(4)));
typedef float f32x4 __attribute__((ext_vector_type(4)));
typedef unsigned u32x2 __attribute__((ext_vector_type(2)));
typedef unsigned u32x4 __attribute__((ext_vector_type(4)));

constexpr int T_TOK = 32768, DM = 1024, SEQ = 2048, NB = 16, DFF = 2816, NMEM = 256, TMEM = 4096;
constexpr float LOG2E = 1.4426950408889634f;
constexpr float EPS = 1e-6f;

constexpr size_t W_GU1 = 0, W_DN1 = 5767168, W_GU2 = 8650752, W_DN2 = 14417920, W_Q = 17301504, W_K = 18350080, W_V = 19398656, W_O = 20447232, W_MIX = 21495808;
constexpr size_t W_IN = W_MIX, W_UQ = W_IN + 3670016, W_KN = W_UQ + 393216, W_VV = W_KN + 131072, W_OY = W_VV + 131072, W_OO = W_OY + 1048576;
constexpr size_t W_FT = W_MIX, W_FOLD = W_FT + 1048576;
constexpr size_t WB_ELEMS = 27394048;
constexpr size_t OFF_WB = 0;
constexpr size_t OFF_FSEQ = OFF_WB + WB_ELEMS * 2;
constexpr size_t OFF_TCH = OFF_FSEQ + 8388608;
constexpr size_t OFF_HB = OFF_TCH + 262144;
constexpr size_t OFF_MEMB = OFF_HB + 67108864;
constexpr size_t OFF_KMEM = OFF_MEMB + 8388608;
constexpr size_t OFF_VTM = OFF_KMEM + 8388608;
constexpr size_t OFF_ROWSS = OFF_VTM + 8388608;
constexpr size_t RS_H0 = 0, RS_H1 = (size_t)T_TOK * 16, RS_CQ = (size_t)T_TOK * 32, RS_CKV = (size_t)T_TOK * 48, RS_G = (size_t)T_TOK * 64, RS_TOTAL = (size_t)T_TOK * 80;
constexpr size_t OFF_MEMSS = OFF_ROWSS + RS_TOTAL * 4;
constexpr size_t OFF_SCR = OFF_MEMSS + 4096 * 16 * 4;
constexpr size_t S_ACT = 0;
constexpr size_t S_XQ = 0, S_XO = 67108864;
constexpr size_t S_UT = 0, S_YCS = 67108864;
constexpr size_t S_Z = 0, S_XBC = 100663296, S_QB = S_XBC, S_KN = S_XBC + 50331648, S_CQ = 201326592, S_CKV = 234881024, S_DTRAW = 251658240,
                 S_KROPE = 255852544, S_XT = 257949696, S_BCC = 325058560, S_CUM = 358612992, S_END = 367001600;
constexpr size_t OFF_BAR = OFF_SCR + S_END;
constexpr size_t WS_NEED = OFF_BAR + 16384;
constexpr size_t CUM_ARR = (size_t)T_TOK * 16;

struct Args { const void* in[29]; float* out; unsigned char* ws; int ph_lo, ph_hi; };

__device__ __forceinline__ unsigned cvt_pk_bf16(float lo, float hi) { unsigned r; asm volatile("v_cvt_pk_bf16_f32 %0, %1, %2" : "=v"(r) : "v"(lo), "v"(hi)); return r; }
__device__ __forceinline__ float bf2f(unsigned short b) { return __uint_as_float(((unsigned)b) << 16); }
__device__ __forceinline__ float bflo(unsigned u) { return __uint_as_float(u << 16); }
__device__ __forceinline__ float bfhi(unsigned u) { return __uint_as_float(u & 0xffff0000u); }
__device__ __forceinline__ float fexp2(float x) { return __builtin_amdgcn_exp2f(x); }
__device__ __forceinline__ float frcp(float x) { return __builtin_amdgcn_rcpf(x); }
__device__ __forceinline__ float silu_f(float g) { return g * frcp(1.0f + fexp2(-g * LOG2E)); }
__device__ __forceinline__ float rstd_of(float ss, float inv_dim) { return rsqrtf(ss * inv_dim + EPS); }
__device__ __forceinline__ float shfl_xor_f(float v, int m) { return __shfl_xor(v, m, 64); }
__device__ __forceinline__ float ss_sum(const float* p, size_t row, int) {
    const f32x4* q = (const f32x4*)(p + row * 16); const f32x4 a = q[0], b = q[1], c = q[2], d = q[3];
    const f32x4 t = (a + b) + (c + d); return (t[0] + t[1]) + (t[2] + t[3]); }

__device__ __forceinline__ int opaque_tid() { int t = threadIdx.x; asm volatile("" : "+v"(t)); return t; }

__device__ __forceinline__ int xcd_item(int trip, int n_items) {
    const int x = blockIdx.x & 7, s = blockIdx.x >> 3, per = n_items >> 3, nslot = gridDim.x >> 3;
    const int local = trip * nslot + s; return local < per ? x * per + local : -1;
}

constexpr int BM = 256, BK = 64, HALF = 128, HTB = HALF * BK * 2, STAGE_BYTES = 8 * HTB, NXCD = 8, WGM = 8;
constexpr int LDS_XST = STAGE_BYTES, LDS_RSC = STAGE_BYTES + 256, LDS_BYTES = LDS_RSC + 512 * 36;
__device__ __forceinline__ int lds_byte(int r, int c) { const int st = (r >> 4) * 2 + (c >> 5), rr = r & 15, cc = c & 31, ob = rr * 64 + cc * 2; return st * 1024 + (ob ^ (((ob >> 9) & 1) << 5)); }
__device__ __forceinline__ void stage_rc(int b, int& R, int& C) { const int st = b / 1024, sb = b % 1024, swz = sb ^ (((sb >> 9) & 1) << 5); R = (st >> 1) * 16 + swz / 64; C = (st & 1) * 32 + (swz % 64) / 2; }

__device__ __forceinline__ int perm32(int rho) { const int n = rho >> 4, i = rho & 15; return 8 * (i >> 2) + 4 * n + (i & 3); }
struct Unit { int pm, pn, pz; };
struct Gemm { const bf16_t* A; const bf16_t* Bt; int lda, ldb, K, nM, nN, nZ, zd, rot; long sA1, sA2, sB1, sB2; };
__device__ __forceinline__ Gemm mk_gemm(const bf16_t* A, int lda, const bf16_t* Bt, int ldb, int K, int nM, int nN) {
    Gemm g; g.A = A; g.Bt = Bt; g.lda = lda; g.ldb = ldb; g.K = K; g.nM = nM; g.nN = nN; g.nZ = 1; g.zd = 1; g.rot = 0; g.sA1 = g.sA2 = g.sB1 = g.sB2 = 0; return g; }

__device__ __forceinline__ bool next_unit(const Gemm& g, int i, Unit& u) {
    const int nwg = g.nM * g.nN;
    const long L = (long)i * gridDim.x + (int)((blockIdx.x + gridDim.x - (unsigned)g.rot) % gridDim.x); if (L >= (long)nwg * g.nZ) return false;
    u.pz = (int)(L / nwg); int wgid = (int)(L % nwg);
    { const int q = nwg / NXCD, r = nwg % NXCD, xcd = wgid % NXCD, off = wgid / NXCD; wgid = (xcd < r ? xcd * (q + 1) : r * (q + 1) + (xcd - r) * q) + off; }
    const int nig = WGM * g.nN, gid = wgid / nig, fm = gid * WGM, gsz = (g.nM - fm) < WGM ? (g.nM - fm) : WGM;
    u.pm = fm + ((wgid % nig) % gsz); u.pn = (wgid % nig) / gsz; return true;
}
__device__ __forceinline__ const char* unit_A(const Gemm& g, const Unit& u) { return (const char*)(g.A + (size_t)(u.pz / g.zd) * g.sA1 + (size_t)(u.pz % g.zd) * g.sA2 + (size_t)u.pm * BM * g.lda); }
__device__ __forceinline__ const char* unit_B(const Gemm& g, const Unit& u) { return (const char*)(g.Bt + (size_t)(u.pz / g.zd) * g.sB1 + (size_t)(u.pz % g.zd) * g.sB2 + (size_t)u.pn * BM * g.ldb); }

template <class Epi>
__device__ __forceinline__ void gemm_phase(LAS unsigned char* lds, const Gemm g, const Epi& E) {
    int tid_ = threadIdx.x; asm volatile("" : "+v"(tid_));
    const int tid = tid_, wid = __builtin_amdgcn_readfirstlane(tid >> 6), lane = tid & 63, wr = wid >> 2, wc = wid & 3, fr = lane & 15, fq = lane >> 4;
    const int K = g.K, nt = K / BK;
    unsigned voffA[2], voffB[2];
#pragma unroll
    for (int i = 0; i < 2; ++i) { int R, C; stage_rc(tid * 16 + i * 8192, R, C);
        const int Rb = Epi::PERM ? ((R & ~31) + perm32(R & 31)) : R;
        voffA[i] = (unsigned)(R * g.lda + C) * 2u; voffB[i] = (unsigned)(Rb * g.ldb + C) * 2u; }
    const size_t kstep = (size_t)(BK * 2);
    const size_t hstepA = (size_t)HALF * g.lda * 2, hstepB = (size_t)HALF * g.ldb * 2;
    const unsigned ldsw = (unsigned)wid * 1024u;
    const int aoff = lds_byte(wr * 64 + fr, fq * 8), boff = lds_byte(wc * 32 + fr, fq * 8);
#define PG8_SA(b, h) (((b) * 2 + (h)) * HTB)
#define PG8_SB(b, h) ((4 + (b) * 2 + (h)) * HTB)
#define PG8_STAGE(bufoff, gbase, voff) do { _Pragma("unroll") for (int _i = 0; _i < 2; ++_i) \
        __builtin_amdgcn_global_load_lds((const unsigned*)((const char*)(gbase) + (voff)[_i]), (LAS unsigned*)(lds + (bufoff) + ldsw + _i * 8192), 16, 0, 0); } while (0)
#define PG8_LDA(dst, b, h) do { _Pragma("unroll") for (int m = 0; m < 4; ++m) _Pragma("unroll") for (int k = 0; k < 2; ++k) dst[m][k] = *(const LAS bf16x8*)(lds + PG8_SA(b, h) + aoff + m * 2048 + k * 1024); } while (0)
#define PG8_LDB(dst, b, h) do { _Pragma("unroll") for (int n = 0; n < 2; ++n) _Pragma("unroll") for (int k = 0; k < 2; ++k) dst[n][k] = *(const LAS bf16x8*)(lds + PG8_SB(b, h) + boff + n * 2048 + k * 1024); } while (0)
#define PG8_MMA(ai, bj, At, Bt) do { __builtin_amdgcn_s_setprio(1); _Pragma("unroll") for (int m = 0; m < 4; ++m) _Pragma("unroll") for (int n = 0; n < 2; ++n) _Pragma("unroll") for (int k = 0; k < 2; ++k) \
        acc[ai][bj][m][n] = __builtin_amdgcn_mfma_f32_16x16x32_bf16(Bt[n][k], At[m][k], acc[ai][bj][m][n], 0, 0, 0); __builtin_amdgcn_s_setprio(0); } while (0)
#define PG8_WAIT_V(n) asm volatile("s_waitcnt vmcnt(" #n ")" ::: "memory")
#define PG8_WAIT_L(n) asm volatile("s_waitcnt lgkmcnt(" #n ")" ::: "memory")
#define PG8_BAR __builtin_amdgcn_s_barrier()
#define PG8_SCHED __builtin_amdgcn_sched_barrier(0)
    Unit cur, nxt; int ui = 0;
    if (!next_unit(g, 0, cur)) return;
    f32x4 acc[2][2][4][2];
#pragma unroll
    for (int a = 0; a < 2; ++a)
#pragma unroll
        for (int b = 0; b < 2; ++b)
#pragma unroll
            for (int m = 0; m < 4; ++m)
#pragma unroll
                for (int n = 0; n < 2; ++n) acc[a][b][m][n] = (f32x4){0.f, 0.f, 0.f, 0.f};
    bf16x8 At[4][2], B0[2][2], B1[2][2];
    const char* cA = unit_A(g, cur); const char* cB = unit_B(g, cur);
    PG8_STAGE(PG8_SB(0, 0), cB, voffB); PG8_STAGE(PG8_SA(0, 0), cA, voffA); PG8_STAGE(PG8_SB(0, 1), cB + hstepB, voffB); PG8_STAGE(PG8_SA(0, 1), cA + hstepA, voffA);
    if (wr == 1) PG8_BAR;
    PG8_WAIT_V(4); PG8_BAR;
    PG8_STAGE(PG8_SB(1, 0), cB + kstep, voffB); PG8_STAGE(PG8_SA(1, 0), cA + kstep, voffA); PG8_STAGE(PG8_SB(1, 1), cB + hstepB + kstep, voffB);
    PG8_WAIT_V(6); PG8_BAR;
    for (;;) {
        const bool has_next = next_unit(g, ui + 1, nxt);
        const char* nA = has_next ? unit_A(g, nxt) : cA; const char* nB = has_next ? unit_B(g, nxt) : cB;
        for (int t = 0; t < nt; t += 2) {
            const bool last = (t == nt - 2);
            const char* a1 = cA + (size_t)(t + 1) * kstep;
            const char* a2 = last ? nA : cA + (size_t)(t + 2) * kstep; const char* b2 = last ? nB : cB + (size_t)(t + 2) * kstep;
            const char* a3 = a2 + kstep; const char* b3 = b2 + kstep;
            PG8_LDB(B0, 0, 0); PG8_SCHED; PG8_LDA(At, 0, 0); PG8_STAGE(PG8_SA(1, 1), a1 + hstepA, voffA);
            PG8_WAIT_L(8); PG8_BAR; PG8_WAIT_L(0); PG8_MMA(0, 0, At, B0); PG8_BAR; PG8_SCHED;
            PG8_LDB(B1, 0, 1); PG8_STAGE(PG8_SB(0, 0), b2, voffB);
            PG8_BAR; PG8_WAIT_L(0); PG8_MMA(0, 1, At, B1); PG8_BAR;
            PG8_LDA(At, 0, 1); PG8_STAGE(PG8_SA(0, 0), a2, voffA);
            PG8_BAR; PG8_WAIT_L(0); PG8_MMA(1, 0, At, B0); PG8_BAR; PG8_SCHED;
            PG8_STAGE(PG8_SB(0, 1), b2 + hstepB, voffB);
            PG8_WAIT_V(6); PG8_BAR; PG8_MMA(1, 1, At, B1); PG8_BAR;
            PG8_LDB(B0, 1, 0); PG8_SCHED; PG8_LDA(At, 1, 0); PG8_STAGE(PG8_SA(0, 1), a2 + hstepA, voffA);
            PG8_WAIT_L(8); PG8_BAR; PG8_WAIT_L(0); PG8_MMA(0, 0, At, B0); PG8_BAR; PG8_SCHED;
            PG8_LDB(B1, 1, 1); PG8_STAGE(PG8_SB(1, 0), b3, voffB);
            PG8_BAR; PG8_WAIT_L(0); PG8_MMA(0, 1, At, B1); PG8_BAR;
            PG8_LDA(At, 1, 1); PG8_STAGE(PG8_SA(1, 0), a3, voffA);
            PG8_BAR; PG8_WAIT_L(0); PG8_MMA(1, 0, At, B0); PG8_BAR; PG8_SCHED;
            PG8_STAGE(PG8_SB(1, 1), b3 + hstepB, voffB);
            PG8_WAIT_V(6); PG8_BAR; PG8_MMA(1, 1, At, B1); PG8_BAR;
        }
        E(acc, cur, wr, wc, fr, fq);
        if (!has_next) break;
#pragma unroll
        for (int a = 0; a < 2; ++a)
#pragma unroll
            for (int b = 0; b < 2; ++b)
#pragma unroll
                for (int m = 0; m < 4; ++m)
#pragma unroll
                    for (int n = 0; n < 2; ++n) acc[a][b][m][n] = (f32x4){0.f, 0.f, 0.f, 0.f};
        cur = nxt; cA = nA; cB = nB; ++ui;
    }
    PG8_WAIT_V(0);
    if (wr == 0) PG8_BAR;
    PG8_BAR;
#undef PG8_SA
#undef PG8_SB
#undef PG8_STAGE
#undef PG8_LDA
#undef PG8_LDB
#undef PG8_MMA
#undef PG8_WAIT_V
#undef PG8_WAIT_L
#undef PG8_BAR
#undef PG8_SCHED
}

typedef f32x4 AccT[2][2][4][2];
#define EPI_ROWS_BEGIN _Pragma("unroll") for (int ai = 0; ai < 2; ++ai) _Pragma("unroll") for (int m = 0; m < 4; ++m) { const int row = u.pm * BM + ai * HALF + wr * 64 + m * 16 + fr;
#define EPI_ROWS_END }
#define EPI_RS_BATCH(RSV, PTR, W, INVDIM) float RSV[8]; { LAS float* _c = rsc; \
    if ((PTR) && __float_as_int(_c[0]) == u.pm) { _Pragma("unroll") for (int _k = 0; _k < 8; ++_k) RSV[_k] = _c[1 + _k]; }       \
    else { float _s[8]; _Pragma("unroll") for (int _k = 0; _k < 8; ++_k) { const int _row = u.pm * BM + (_k >> 2) * HALF + wr * 64 + (_k & 3) * 16 + fr; _s[_k] = (PTR) ? ss_sum((PTR), (size_t)_row, (W)) : 0.f; } \
        _Pragma("unroll") for (int _k = 0; _k < 8; ++_k) RSV[_k] = (PTR) ? rstd_of(_s[_k], (INVDIM)) : 1.0f; \
        if (PTR) { _c[0] = __int_as_float(u.pm); _Pragma("unroll") for (int _k = 0; _k < 8; ++_k) _c[1 + _k] = RSV[_k]; } } }

struct EpiSwiglu {
    static constexpr bool PERM = true;
    bf16_t* act; const float* rss; int rss_w; LAS float* rsc;
    __device__ __forceinline__ void operator()(AccT& acc, const Unit& u, int wr, int wc, int fr, int fq) const {
        EPI_RS_BATCH(rsv, rss, rss_w, 1.0f / DM)
        EPI_ROWS_BEGIN
            const float rs = rsv[ai * 4 + m];
            bf16_t* rp = act + (size_t)row * DFF + u.pn * 128 + wc * 32 + 8 * fq;
            unsigned o[4];
#pragma unroll
            for (int n = 0; n < 2; ++n) { f32x4 gv = acc[ai][0][m][n] * rs, uv = acc[ai][1][m][n] * rs;
                o[2 * n] = cvt_pk_bf16(silu_f(gv[0]) * uv[0], silu_f(gv[1]) * uv[1]); o[2 * n + 1] = cvt_pk_bf16(silu_f(gv[2]) * uv[2], silu_f(gv[3]) * uv[3]); }
            __builtin_nontemporal_store((u32x4){o[0], o[1], o[2], o[3]}, (u32x4*)rp);
        EPI_ROWS_END
    }
};
struct EpiResid {
    static constexpr bool PERM = true;
    const float* hin; float* hout; bf16_t* hb; float* ss_out; const float* rss; int rss_w; float rss_inv_dim; float alpha; LAS float* rsc;
    __device__ __forceinline__ void operator()(AccT& acc, const Unit& u, int wr, int wc, int fr, int fq) const {
        EPI_RS_BATCH(rsv, rss, rss_w, rss_inv_dim)
#pragma unroll
        for (int ah = 0; ah < 4; ++ah) { const int ai = ah >> 1, m0 = (ah & 1) * 2;
            f32x4 hv[4][2][2];
#pragma unroll
            for (int m = m0; m < m0 + 2; ++m) { const int row = u.pm * BM + ai * HALF + wr * 64 + m * 16 + fr; const size_t base = (size_t)row * DM + u.pn * BM + wc * 32 + 8 * fq;
#pragma unroll
                for (int bj = 0; bj < 2; ++bj)
#pragma unroll
                    for (int n = 0; n < 2; ++n) hv[m][bj][n] = *(const f32x4*)(hin + base + bj * HALF + n * 4); }
#pragma unroll
            for (int m = m0; m < m0 + 2; ++m) { const int row = u.pm * BM + ai * HALF + wr * 64 + m * 16 + fr; const size_t base = (size_t)row * DM + u.pn * BM + wc * 32 + 8 * fq;
                const float sc = alpha * rsv[ai * 4 + m]; float ss = 0.f;
#pragma unroll
                for (int bj = 0; bj < 2; ++bj) { const size_t o = base + bj * HALF;
                    const f32x4 ha = hv[m][bj][0] + acc[ai][bj][m][0] * sc, hc = hv[m][bj][1] + acc[ai][bj][m][1] * sc;
                    *(f32x4*)(hout + o) = ha; *(f32x4*)(hout + o + 4) = hc;
                    if (hb) *(u32x4*)(hb + o) = (u32x4){cvt_pk_bf16(ha[0], ha[1]), cvt_pk_bf16(ha[2], ha[3]), cvt_pk_bf16(hc[0], hc[1]), cvt_pk_bf16(hc[2], hc[3])};
                    ss += ha[0] * ha[0] + ha[1] * ha[1] + ha[2] * ha[2] + ha[3] * ha[3] + hc[0] * hc[0] + hc[1] * hc[1] + hc[2] * hc[2] + hc[3] * hc[3]; }
                if (ss_out) { ss += shfl_xor_f(ss, 16); ss += shfl_xor_f(ss, 32); if (fq == 0) ss_out[(size_t)row * 16 + u.pn * 4 + wc] = ss; } }
        }
    }
};
template <int MODE, bool ROPE> struct EpiStore {
    static constexpr bool PERM = !ROPE;
    bf16_t* out; long ldc; const float* rss; int rss_w; float rs_inv_dim; const float* css; int css_w; float cs_inv_dim; long zoff; const int* pos; LAS float* rsc;
    __device__ __forceinline__ void operator()(AccT& acc, const Unit& u, int wr, int wc, int fr, int fq) const {
        bf16_t* ob = out + (size_t)u.pz * zoff; int rbase = u.pm * BM, cbase = u.pn * BM;
        if (MODE == 1) { const int b = u.pn >> 2; ob = out + ((size_t)b * SEQ) * 2048; cbase = (u.pn & 3) * BM; }
        if (css) {
#pragma unroll
            for (int bj = 0; bj < 2; ++bj)
#pragma unroll
                for (int n = 0; n < 2; ++n) { const size_t c0 = (size_t)(u.pn * BM + bj * HALF + wc * 32 + (PERM ? 8 * fq + 4 * n : n * 16 + 4 * fq));
                    const f32x4 cv = (f32x4){rstd_of(ss_sum(css, c0, css_w), cs_inv_dim), rstd_of(ss_sum(css, c0 + 1, css_w), cs_inv_dim), rstd_of(ss_sum(css, c0 + 2, css_w), cs_inv_dim), rstd_of(ss_sum(css, c0 + 3, css_w), cs_inv_dim)};
#pragma unroll
                    for (int ai = 0; ai < 2; ++ai)
#pragma unroll
                        for (int m = 0; m < 4; ++m) acc[ai][bj][m][n] *= cv; }
        }
        EPI_RS_BATCH(rsv, rss, rss_w, rs_inv_dim)
        EPI_ROWS_BEGIN
            const float rs = rsv[ai * 4 + m];
            int lrow = rbase + ai * HALF + wr * 64 + m * 16 + fr; int mrow = -1; float msgn = 1.0f; long mcoff = 0;
            if (MODE == 1) {
                const int r = lrow; if (r <= 1024) { mrow = (r >= 1 && r < 1024) ? 2048 - r : -1; } else { lrow = r - 1024; mrow = 2048 - lrow; mcoff = 1024; msgn = -1.0f; }
                if (r == 1024) { bf16_t* z0 = ob + 1024 + cbase + wc * 32 + 8 * fq; bf16_t* z1 = z0 + (size_t)1024 * 2048; const u32x4 zz = (u32x4){0u, 0u, 0u, 0u};
#pragma unroll
                    for (int bj = 0; bj < 2; ++bj) { *(u32x4*)(z0 + bj * HALF) = zz; *(u32x4*)(z1 + bj * HALF) = zz; } } }
            bf16_t* rp = ob + (size_t)lrow * ldc + mcoff + cbase + wc * 32 + (PERM ? 8 : 4) * fq;
            float fpos = 0.f; if (ROPE) fpos = (float)pos[row];
#pragma unroll
            for (int bj = 0; bj < 2; ++bj) {
                f32x4 v0 = acc[ai][bj][m][0] * rs, v1 = acc[ai][bj][m][1] * rs;
                if (ROPE) { const int G = (u.pn * BM + bj * HALF + wc * 32) >> 5;
                    if (G % 3 == 2) {
#pragma unroll
                        for (int e = 0; e < 4; ++e) { const int fi = 4 * fq + e; const float inv = fexp2(-(float)fi * (13.287712379549449f / 16.0f));
                            float t = fpos * inv * 0.15915494309189535f; t -= floorf(t);
                            const float sn = __builtin_amdgcn_sinf(t), cn = __builtin_amdgcn_cosf(t);
                            const float x1 = v0[e], x2 = v1[e]; v0[e] = x1 * cn - x2 * sn; v1[e] = x1 * sn + x2 * cn; } } }
                u32x2 p0, p1; p0.x = cvt_pk_bf16(v0[0], v0[1]); p0.y = cvt_pk_bf16(v0[2], v0[3]); p1.x = cvt_pk_bf16(v1[0], v1[1]); p1.y = cvt_pk_bf16(v1[2], v1[3]);
                if (PERM) *(u32x4*)(rp + bj * HALF) = (u32x4){p0.x, p0.y, p1.x, p1.y}; else { *(u32x2*)(rp + bj * HALF) = p0; *(u32x2*)(rp + bj * HALF + 16) = p1; }
                if (MODE == 1 && mrow >= 0) { bf16_t* mp = ob + (size_t)mrow * ldc + mcoff + cbase + wc * 32 + 8 * fq;
                    if (msgn < 0.f) { p0.x ^= 0x80008000u; p0.y ^= 0x80008000u; p1.x ^= 0x80008000u; p1.y ^= 0x80008000u; }
                    *(u32x4*)(mp + bj * HALF) = (u32x4){p0.x, p0.y, p1.x, p1.y}; } }
        EPI_ROWS_END
    }
};
struct EpiWin {
    static constexpr bool PERM = false;
    unsigned char* scr; const float* rss; int rss_w; float* ss_cq; float* ss_ckv; const int* pos; LAS float* rsc;
    __device__ __forceinline__ void operator()(AccT& acc, const Unit& u, int wr, int wc, int fr, int fq) const {
        const int pn = u.pn;
        EPI_RS_BATCH(rsv, rss, rss_w, 1.0f / DM)
        EPI_ROWS_BEGIN
            const float rs = rsv[ai * 4 + m];
            if (pn < 13) {
                bf16_t* rp; float* ssp = nullptr; size_t ssi = 0;
                if (pn < 4) rp = (bf16_t*)(scr + S_Z) + (size_t)row * 1536 + pn * BM;
                else if (pn < 10) rp = (bf16_t*)(scr + S_XBC) + (size_t)row * 1536 + (pn - 4) * BM;
                else if (pn < 12) { rp = (bf16_t*)(scr + S_CQ) + (size_t)row * 512 + (pn - 10) * BM; ssp = ss_cq; ssi = (size_t)row * 16 + (pn - 10) * 4 + wc; }
                else { rp = (bf16_t*)(scr + S_CKV) + (size_t)row * 256; ssp = ss_ckv; ssi = (size_t)row * 16 + wc; }
                rp += wc * 32 + 4 * fq; float ss = 0.f;
#pragma unroll
                for (int bj = 0; bj < 2; ++bj)
#pragma unroll
                    for (int n = 0; n < 2; ++n) { f32x4 v = acc[ai][bj][m][n] * rs; u32x2 p; p.x = cvt_pk_bf16(v[0], v[1]); p.y = cvt_pk_bf16(v[2], v[3]);
                        *(u32x2*)(rp + bj * HALF + n * 16) = p; ss += v[0] * v[0] + v[1] * v[1] + v[2] * v[2] + v[3] * v[3]; }
                if (ssp) { ss += shfl_xor_f(ss, 16); ss += shfl_xor_f(ss, 32);
                    if (fq == 0) { ssp[ssi] = ss; if (pn == 12) { ssp[ssi + 4] = 0.f; ssp[ssi + 8] = 0.f; ssp[ssi + 12] = 0.f; } else ssp[ssi + 8] = 0.f; } }
            } else {
                if (wc == 0) {
                    float* dp = (float*)(scr + S_DTRAW) + (size_t)row * 32 + 4 * fq;
                    *(f32x4*)dp = acc[ai][0][m][0] * rs; *(f32x4*)(dp + 16) = acc[ai][0][m][1] * rs;
                } else if (wc == 1) {
                    f32x4 v0 = acc[ai][0][m][0] * rs, v1 = acc[ai][0][m][1] * rs; const float fpos = (float)pos[row];
#pragma unroll
                    for (int e = 0; e < 4; ++e) { const int fi = 4 * fq + e; const float inv = fexp2(-(float)fi * (13.287712379549449f / 16.0f));
                        float t = fpos * inv * 0.15915494309189535f; t -= floorf(t);
                        const float sn = __builtin_amdgcn_sinf(t), cn = __builtin_amdgcn_cosf(t);
                        const float x1 = v0[e], x2 = v1[e]; v0[e] = x1 * cn - x2 * sn; v1[e] = x1 * sn + x2 * cn; }
                    bf16_t* kp = (bf16_t*)(scr + S_KROPE) + (size_t)row * 32 + 4 * fq;
                    u32x2 p0, p1; p0.x = cvt_pk_bf16(v0[0], v0[1]); p0.y = cvt_pk_bf16(v0[2], v0[3]); p1.x = cvt_pk_bf16(v1[0], v1[1]); p1.y = cvt_pk_bf16(v1[2], v1[3]);
                    *(u32x2*)kp = p0; *(u32x2*)(kp + 16) = p1;
                }
            }
        EPI_ROWS_END
    }
};

__device__ __forceinline__ int colmap(int map, int j) {
    switch (map) {
        case 1: { const int t = j >> 8, w = j & 255; return (w >> 7) * DFF + t * 128 + (w & 127); }
        case 2: return j < 2560 ? j : (j < 3328 ? j + 32 : (j < 3360 ? j - 768 : (j < 3392 ? j : -1)));
        case 3: return (j >> 6) * 128 + (j & 63);
        case 4: return (j >> 6) * 128 + 64 + (j & 63);
        default: return j;
    }
}
__device__ __attribute__((noinline)) void convT(LAS float* tile, const float* src, int ldsrc, int K, bf16_t* dst, int ldd, int ndst, int map, const float* kscale, float scalar) {
    const int tid = opaque_tid(), nkt = K >> 6, ntiles = (ndst >> 8) * nkt;
    for (int t = blockIdx.x; t < ntiles; t += gridDim.x) {
        const int n0 = (t / nkt) << 8, k0 = (t % nkt) << 6;
        { const int k = tid >> 3, nv = tid & 7; f32x4 va[4], vb[4];
#pragma unroll
          for (int j = 0; j < 4; ++j) { const int sc = colmap(map, n0 + 64 * j + 8 * nv); va[j] = (f32x4){0.f, 0.f, 0.f, 0.f}; vb[j] = va[j];
              if (sc >= 0) { const float* p = src + (size_t)(k0 + k) * ldsrc + sc; va[j] = *(const f32x4*)p; vb[j] = *(const f32x4*)(p + 4); } }
          const float s = (kscale ? kscale[k0 + k] : 1.0f) * scalar;
#pragma unroll
          for (int j = 0; j < 4; ++j) { LAS float* tp = tile + k * 257 + 64 * j + 8 * nv;
              tp[0] = va[j][0] * s; tp[1] = va[j][1] * s; tp[2] = va[j][2] * s; tp[3] = va[j][3] * s; tp[4] = vb[j][0] * s; tp[5] = vb[j][1] * s; tp[6] = vb[j][2] * s; tp[7] = vb[j][3] * s; } }
        __syncthreads();
        { const int kv = tid & 7;
#pragma unroll
          for (int j = 0; j < 4; ++j) { const int n = (tid >> 3) + 64 * j; const LAS float* tp = tile + (8 * kv) * 257 + n;
              u32x4 o; o.x = cvt_pk_bf16(tp[0], tp[257]); o.y = cvt_pk_bf16(tp[514], tp[771]); o.z = cvt_pk_bf16(tp[1028], tp[1285]); o.w = cvt_pk_bf16(tp[1542], tp[1799]);
              *(u32x4*)(dst + (size_t)(n0 + n) * ldd + k0 + 8 * kv) = o; } }
        __syncthreads();
    }
}
__device__ void convert_layer(const Args& a, int l, LAS float* tile) {
    bf16_t* wb = (bf16_t*)(a.ws + OFF_WB);
    const float* const* in = (const float* const*)a.in;
    convT(tile, in[6] + (size_t)l * DM * 2 * DFF, 2 * DFF, DM, wb + W_GU1, DM, 2 * DFF, 1, in[5] + l * DM, 1.0f);
    convT(tile, in[7] + (size_t)l * DFF * DM, DM, DFF, wb + W_DN1, DFF, DM, 0, nullptr, 1.0f);
    convT(tile, in[14] + (size_t)l * DM * 2 * DFF, 2 * DFF, DM, wb + W_GU2, DM, 2 * DFF, 1, in[13] + l * DM, 1.0f);
    convT(tile, in[15] + (size_t)l * DFF * DM, DM, DFF, wb + W_DN2, DFF, DM, 0, nullptr, 1.0f);
    convT(tile, in[10] + (size_t)l * DM * DM, DM, DM, wb + W_Q, DM, DM, 0, in[9] + l * DM, 0.0625f * LOG2E);
    convT(tile, in[11] + (size_t)l * DM * 2 * DM, 2 * DM, DM, wb + W_K, DM, DM, 0, in[3], 1.0f);
    convT(tile, in[11] + (size_t)l * DM * 2 * DM + DM, 2 * DM, DM, wb + W_V, DM, DM, 0, in[3], 1.0f);
    convT(tile, in[12] + (size_t)l * DM * DM, DM, DM, wb + W_O, DM, DM, 0, nullptr, 1.0f);
    if ((l & 1) == 0) { const int e = l >> 1;
        convT(tile, in[16] + (size_t)e * DM * 3392, 3392, DM, wb + W_IN, DM, 3584, 2, in[8] + l * DM, 1.0f);
        convT(tile, in[24] + (size_t)e * 512 * 768, 768, 512, wb + W_UQ, 512, 768, 0, in[23] + e * 512, 0.10206207261596577f * LOG2E);
        convT(tile, in[26] + (size_t)e * 256 * 1024, 1024, 256, wb + W_KN, 256, 512, 3, in[25] + e * 256, 1.0f);
        convT(tile, in[26] + (size_t)e * 256 * 1024, 1024, 256, wb + W_VV, 256, 512, 4, in[25] + e * 256, 1.0f);
        convT(tile, in[27] + (size_t)e * 1536 * 1024, 1024, 1024, wb + W_OY, 1536, 1024, 0, in[22] + e * 1024, 1.0f);
        convT(tile, in[27] + (size_t)e * 1536 * 1024 + (size_t)1024 * 1024, 1024, 512, wb + W_OY + 1024, 1536, 1024, 0, nullptr, 1.0f);
    } else { const int o = l >> 1;
        convT(tile, in[28] + (size_t)o * DM * DM, DM, DM, wb + W_FT, DM, DM, 0, nullptr, 1.0f);
    }
}

__device__ void rows_to_bf16(const float* src, bf16_t* dst, float* ss, int nrows, int w) {
    const int tid = opaque_tid(); const int lane = tid & 63, wv = tid >> 6;
    const int per = nrows >> 3, rbeg = (int)(blockIdx.x & 7) * per;
    for (int rl = ((int)(blockIdx.x >> 3) * 8 + wv) * 4; rl < per; rl += (int)(gridDim.x >> 3) * 32) { const int r0 = rbeg + rl;
        f32x4 v[4][4];
#pragma unroll
        for (int q = 0; q < 4; ++q)
#pragma unroll
            for (int k = 0; k < 4; ++k) v[q][k] = *(const f32x4*)(src + (size_t)(r0 + q) * DM + lane * 4 + k * 256);
#pragma unroll
        for (int q = 0; q < 4; ++q) { bf16_t* qd = dst + (size_t)(r0 + q) * DM + lane * 4; float s = 0.f;
#pragma unroll
            for (int k = 0; k < 4; ++k) { const f32x4 x = v[q][k]; s += x[0] * x[0] + x[1] * x[1] + x[2] * x[2] + x[3] * x[3];
                u32x2 o; o.x = cvt_pk_bf16(x[0], x[1]); o.y = cvt_pk_bf16(x[2], x[3]); *(u32x2*)(qd + k * 256) = o; }
#pragma unroll
            for (int o = 32; o > 0; o >>= 1) s += shfl_xor_f(s, o);
            if (lane < w) ss[(size_t)(r0 + q) * w + lane] = lane == 0 ? s : 0.f; }
    }
}
__device__ void gen_tables(const Args& a) {
    bf16_t* F = (bf16_t*)(a.ws + OFF_FSEQ); bf16_t* Tc = (bf16_t*)(a.ws + OFF_TCH);
    const size_t gt = (size_t)blockIdx.x * blockDim.x + opaque_tid(), gs = (size_t)gridDim.x * blockDim.x;
    const float scale = 0.001381067932004976f;
    for (size_t i = gt; i < (size_t)2048 * 256; i += gs) {
        const int row = (int)(i >> 8), c0 = (int)(i & 255) * 8, cs = row > 1024 ? 1 : 0, sp = cs ? row - 1024 : row; unsigned w[4];
#pragma unroll
        for (int e = 0; e < 8; e += 2) { float v[2];
#pragma unroll
            for (int x = 0; x < 2; ++x) { const int k = (sp * (c0 + e + x)) & 2047; const float t = (float)k * (1.0f / 2048.0f);
                v[x] = (cs ? __builtin_amdgcn_sinf(t) : __builtin_amdgcn_cosf(t)) * scale; }
            w[e >> 1] = cvt_pk_bf16(v[0], v[1]); }
        *(u32x4*)(F + (size_t)row * 2048 + c0) = (u32x4){w[0], w[1], w[2], w[3]};
    }
    for (size_t i = gt; i < (size_t)2 * 256 * 32; i += gs) {
        const int cs = (int)(i >> 13), c = (int)((i >> 5) & 255), c0 = (int)(i & 31) * 8; unsigned w[4];
#pragma unroll
        for (int e = 0; e < 8; e += 2) { float v[2];
#pragma unroll
            for (int x = 0; x < 2; ++x) { const int k = (c * (c0 + e + x)) & 255; const float t = (float)k * (1.0f / 256.0f);
                v[x] = cs ? -__builtin_amdgcn_sinf(t) : __builtin_amdgcn_cosf(t); }
            w[e >> 1] = cvt_pk_bf16(v[0], v[1]); }
        *(u32x4*)(Tc + (size_t)cs * 65536 + (size_t)c * 256 + c0) = (u32x4){w[0], w[1], w[2], w[3]};
    }
}

__device__ void conv_phase(const Args& a, int e, LAS unsigned char* lds) {
    unsigned char* scr = a.ws + OFF_SCR;
    const bf16_t* xbc = (const bf16_t*)(scr + S_XBC);
    const float* cw = (const float*)a.in[17] + (size_t)e * 5 * 1536; const float* cb = (const float*)a.in[18] + (size_t)e * 1536;
    const int tid = opaque_tid();
    LAS bf16_t* tl = (LAS bf16_t*)lds;
    bf16_t* xT = (bf16_t*)(scr + S_XT);
    for (int trip = 0; ; ++trip) { const int it = xcd_item(trip, NB * 32 * 8); if (it < 0) break;
        const int b = it >> 8, st = (it >> 3) & 31, ct = it & 7, s0 = st * 64, c0 = ct * 128;
        { const int s = tid >> 3, cv = tid & 7; u32x4 xv[2][5];
#pragma unroll
          for (int j = 0; j < 2; ++j)
#pragma unroll
              for (int k = 0; k < 5; ++k) { const int sp = s0 + s + k - 2; xv[j][k] = (u32x4){0u, 0u, 0u, 0u};
                  if (sp >= 0 && sp < SEQ) xv[j][k] = *(const u32x4*)(xbc + ((size_t)b * SEQ + sp) * 1536 + c0 + 64 * j + 8 * cv); }
#pragma unroll
          for (int j = 0; j < 2; ++j) { const int ch = c0 + 64 * j + 8 * cv; float accv[8];
#pragma unroll
              for (int x = 0; x < 8; ++x) accv[x] = cb[ch + x];
#pragma unroll
              for (int k = 0; k < 5; ++k) { const u32x4 v = xv[j][k]; const float* wp = cw + k * 1536 + ch;
                  const f32x4 w0 = *(const f32x4*)wp, w1 = *(const f32x4*)(wp + 4);
                  accv[0] += bflo(v.x) * w0[0]; accv[1] += bfhi(v.x) * w0[1]; accv[2] += bflo(v.y) * w0[2]; accv[3] += bfhi(v.y) * w0[3];
                  accv[4] += bflo(v.z) * w1[0]; accv[5] += bfhi(v.z) * w1[1]; accv[6] += bflo(v.w) * w1[2]; accv[7] += bfhi(v.w) * w1[3]; }
#pragma unroll
              for (int x = 0; x < 8; x += 2) { const unsigned p = cvt_pk_bf16(silu_f(accv[x]), silu_f(accv[x + 1]));
                  tl[(64 * j + 8 * cv + x) * 72 + s] = (bf16_t)(p & 0xffff); tl[(64 * j + 8 * cv + x + 1) * 72 + s] = (bf16_t)(p >> 16); } } }
        __syncthreads();
        { const int sv = tid & 7;
#pragma unroll
          for (int j = 0; j < 2; ++j) { const int ch = (tid >> 3) + 64 * j; const u32x4 v = *(const LAS u32x4*)(tl + ch * 72 + 8 * sv);
              *(u32x4*)(xT + ((size_t)b * 1024 + c0 + ch) * SEQ + s0 + 8 * sv) = v; } }
        __syncthreads();
    }
    bf16_t* bcc = (bf16_t*)(scr + S_BCC);
    for (int trip = 0; ; ++trip) { const int itb = xcd_item(trip, T_TOK / 8); if (itb < 0) break; const size_t i = (size_t)itb * 512 + tid;
        const int row = (int)(i >> 6), ch = 1024 + (int)(i & 63) * 8, s = row & (SEQ - 1); float accv[8];
#pragma unroll
        for (int x = 0; x < 8; ++x) accv[x] = cb[ch + x];
#pragma unroll
        for (int k = 0; k < 5; ++k) { const int sp = s + k - 2;
            if (sp >= 0 && sp < SEQ) { const u32x4 v = *(const u32x4*)(xbc + ((size_t)row + k - 2) * 1536 + ch); const float* wp = cw + k * 1536 + ch;
                const f32x4 w0 = *(const f32x4*)wp, w1 = *(const f32x4*)(wp + 4);
                accv[0] += bflo(v.x) * w0[0]; accv[1] += bfhi(v.x) * w0[1]; accv[2] += bflo(v.y) * w0[2]; accv[3] += bfhi(v.y) * w0[3];
                accv[4] += bflo(v.z) * w1[0]; accv[5] += bfhi(v.z) * w1[1]; accv[6] += bflo(v.w) * w1[2]; accv[7] += bfhi(v.w) * w1[3]; } }
        u32x4 o; o.x = cvt_pk_bf16(silu_f(accv[0]), silu_f(accv[1])); o.y = cvt_pk_bf16(silu_f(accv[2]), silu_f(accv[3]));
        o.z = cvt_pk_bf16(silu_f(accv[4]), silu_f(accv[5])); o.w = cvt_pk_bf16(silu_f(accv[6]), silu_f(accv[7]));
        *(u32x4*)(bcc + (size_t)row * 512 + (ch - 1024)) = o;
    }
    const float* dtraw = (const float*)(scr + S_DTRAW); float* cum = (float*)(scr + S_CUM);
    const float* dtb = (const float*)a.in[19] + e * 32; const float* alog = (const float*)a.in[20] + e * 32;
    const int lane = tid & 63, wv = tid >> 6;
    for (int it = wv * gridDim.x + blockIdx.x; it < NB * 32; it += gridDim.x * 8) {
        const int b = it >> 5, dr = it & 31, dir = dr >> 4, r = dr & 15;
        const float bias = dtb[dr], A = -expf(alog[dr]);
        const float* src = dtraw + ((size_t)b * SEQ + lane * 32) * 32 + dr;
        float xr[32];
#pragma unroll
        for (int k = 0; k < 32; ++k) xr[k] = src[(size_t)k * 32];
        float tot = 0.f;
#pragma unroll
        for (int k = 0; k < 32; ++k) { const float x = xr[k] + bias; const float dt = fmaxf(x, 0.f) + log1pf(expf(-fabsf(x))); xr[k] = dt; tot += dt * A; }
        float incl = tot;
#pragma unroll
        for (int o = 1; o < 64; o <<= 1) { const float v = __shfl_up(incl, o, 64); if (lane >= o) incl += v; }
        float run = incl - tot;
        float* pa = cum + ((size_t)b * SEQ + lane * 32) * 64 + dir * 32 + r; float* pb = pa + 16;
#pragma unroll
        for (int k = 0; k < 32; ++k) { const float dt = xr[k]; const float la = dt * A, l2 = log2f(dt);
            if (dir == 0) { run += la; pa[(size_t)k * 64] = run * LOG2E; pb[(size_t)k * 64] = run * LOG2E - l2; }
            else { pa[(size_t)k * 64] = run * LOG2E; pb[(size_t)k * 64] = run * LOG2E + l2; run += la; } }
    }
}

#define MFMA16(a, b, c) __builtin_amdgcn_mfma_f32_16x16x32_bf16((a), (b), (c), 0, 0, 0)
__device__ __forceinline__ bf16x8 ld_frag16(const LAS bf16_t* p) { return *(const LAS bf16x8*)p; }
__device__ __forceinline__ bf16x8 ld_frag_split(const LAS bf16_t* p) {
    const u32x2 lo = *(const LAS u32x2*)p, hi = *(const LAS u32x2*)(p + 16); u32x4 v = (u32x4){lo.x, lo.y, hi.x, hi.y}; return __builtin_bit_cast(bf16x8, v); }
__device__ __forceinline__ bf16x8 pack_frag(const f32x4& a, const f32x4& b) {
    u32x4 v = (u32x4){cvt_pk_bf16(a[0], a[1]), cvt_pk_bf16(a[2], a[3]), cvt_pk_bf16(b[0], b[1]), cvt_pk_bf16(b[2], b[3])}; return __builtin_bit_cast(bf16x8, v); }

template <int DK, int DK1, int DV, int QT, int PD>
__device__ __forceinline__ void attn_item(LAS unsigned char* lds, const bf16_t* Q, int ldq, const bf16_t* K1, int ldk1, const bf16_t* K2, int ldk2,
                                          const bf16_t* Vt, long ldvt, int nkeys, bf16_t* O, int ldo, const float* osc) {
    constexpr int KS = DK / 32, DT = DV / 16, KSTR = DK + 8, VSTR = 136, BUFE = 128 * KSTR + DV * VSTR;
    LAS bf16_t* Ks0 = (LAS bf16_t*)lds; LAS bf16_t* Vs0 = Ks0 + 128 * KSTR;
    const int tid = opaque_tid(), lane = tid & 63, wv = tid >> 6, i = lane & 15, quad = lane >> 4;
    bf16x8 qf[QT][KS];
#pragma unroll
    for (int qt = 0; qt < QT; ++qt)
#pragma unroll
        for (int ks = 0; ks < KS; ++ks) qf[qt][ks] = *(const bf16x8*)(Q + (size_t)(wv * 16 * QT + qt * 16 + i) * ldq + ks * 32 + quad * 8);
    f32x4 acc_o[DT][QT]; float mrow[QT], lsum[QT];
#pragma unroll
    for (int qt = 0; qt < QT; ++qt) { mrow[qt] = -INFINITY; lsum[qt] = 0.f;
#pragma unroll
        for (int d = 0; d < DT; ++d) acc_o[d][qt] = (f32x4){0.f, 0.f, 0.f, 0.f}; }
    constexpr int KCH = DK / 8, NKQ = (128 * KCH + 511) / 512, NVQ = (DV * 16 + 511) / 512;
    static_assert(128 * KCH == NKQ * 512 && DV * 16 == NVQ * 512, "tile chunks must divide evenly over 512 threads");
    u32x4 pK[NKQ], pV[NVQ];
    typedef const __attribute__((address_space(1))) bf16_t* gbf16p;
    gbf16p kptr[NKQ]; unsigned kstr[NKQ];
#pragma unroll
    for (int q = 0; q < NKQ; ++q) { const int c = tid + q * 512, key = c / KCH, dc = (c % KCH) * 8;
        if (dc < DK1) { kptr[q] = (gbf16p)(K1 + (size_t)key * ldk1 + dc); kstr[q] = (unsigned)ldk1 * 128u; } else { kptr[q] = (gbf16p)(K2 + (size_t)key * ldk2 + (dc - DK1)); kstr[q] = (unsigned)ldk2 * 128u; } }
    const unsigned voff = (unsigned)((tid >> 4) * ldvt + (tid & 15) * 8);
#define ATT_LOAD(k0_) do { \
        _Pragma("unroll") for (int q = 0; q < NKQ; ++q) { pK[q] = *(const __attribute__((address_space(1))) u32x4*)kptr[q]; kptr[q] += kstr[q]; } \
        _Pragma("unroll") for (int q = 0; q < NVQ; ++q) pV[q] = *(const u32x4*)((Vt + (size_t)q * 32 * ldvt + (k0_)) + voff); } while (0)
#define ATT_STORE(B_) do { \
        _Pragma("unroll") for (int q = 0; q < NKQ; ++q) { const int c = tid + q * 512; *(LAS u32x4*)(Ks0 + (B_) * BUFE + (c / KCH) * KSTR + (c % KCH) * 8) = pK[q]; } \
        _Pragma("unroll") for (int q = 0; q < NVQ; ++q) { const int c = tid + q * 512; *(LAS u32x4*)(Vs0 + (B_) * BUFE + (c >> 4) * VSTR + (c & 15) * 8) = pV[q]; } } while (0)
#define ATT_QK(SC, KOFF) do { _Pragma("unroll") for (int kt = 0; kt < 4; ++kt) { \
            _Pragma("unroll") for (int qt = 0; qt < QT; ++qt) SC[kt][qt] = (f32x4){0.f, 0.f, 0.f, 0.f}; \
            _Pragma("unroll") for (int ks = 0; ks < KS; ++ks) { const bf16x8 kf = ld_frag16(Ks + ((KOFF) + kt * 16 + i) * KSTR + ks * 32 + quad * 8); \
                _Pragma("unroll") for (int qt = 0; qt < QT; ++qt) SC[kt][qt] = MFMA16(kf, qf[qt][ks], SC[kt][qt]); } } } while (0)
#define ATT_SOFTMAX_PV(SC, KOFF) do { bf16x8 pf[2][QT]; \
        _Pragma("unroll") for (int qt = 0; qt < QT; ++qt) { float mx = -INFINITY; \
            _Pragma("unroll") for (int kt = 0; kt < 4; ++kt) _Pragma("unroll") for (int j = 0; j < 4; ++j) mx = fmaxf(mx, SC[kt][qt][j]); \
            mx = fmaxf(mx, shfl_xor_f(mx, 16)); mx = fmaxf(mx, shfl_xor_f(mx, 32)); \
            const float mn = fmaxf(mrow[qt], mx), alpha = fexp2(mrow[qt] - mn); mrow[qt] = mn; float ls = 0.f; \
            _Pragma("unroll") for (int kt = 0; kt < 4; ++kt) _Pragma("unroll") for (int j = 0; j < 4; ++j) { const float p = fexp2(SC[kt][qt][j] - mn); SC[kt][qt][j] = p; ls += p; } \
            lsum[qt] = lsum[qt] * alpha + ls; \
            _Pragma("unroll") for (int d = 0; d < DT; ++d) acc_o[d][qt] *= alpha; \
            pf[0][qt] = pack_frag(SC[0][qt], SC[1][qt]); pf[1][qt] = pack_frag(SC[2][qt], SC[3][qt]); } \
        _Pragma("unroll") for (int u = 0; u < 2; ++u) _Pragma("unroll") for (int d = 0; d < DT; ++d) { const bf16x8 vf = ld_frag_split(Vs + (d * 16 + i) * VSTR + (KOFF) + u * 32 + quad * 4); \
            _Pragma("unroll") for (int qt = 0; qt < QT; ++qt) acc_o[d][qt] = MFMA16(vf, pf[u][qt], acc_o[d][qt]); } } while (0)
    const int nt = nkeys >> 7;
    ATT_LOAD(0);
    __syncthreads();
    ATT_STORE(0);
    __syncthreads();
    if (1 < nt) ATT_LOAD(128);
    for (int t = 0; t < nt; ++t) {
        const int bsel = t & 1; LAS bf16_t* Ks = Ks0 + bsel * BUFE; LAS bf16_t* Vs = Vs0 + bsel * BUFE;
        if (t + 1 < nt) { ATT_STORE(bsel ^ 1); if (t + 2 < nt) ATT_LOAD((t + 2) * 128); }
        f32x4 sca[4][QT], scb[4][QT];
        ATT_QK(sca, 0); ATT_QK(scb, 64);
        ATT_SOFTMAX_PV(sca, 0);
        ATT_SOFTMAX_PV(scb, 64);
        __syncthreads();
    }
#pragma unroll
    for (int qt = 0; qt < QT; ++qt) { float l = lsum[qt]; l += shfl_xor_f(l, 16); l += shfl_xor_f(l, 32); float inv = frcp(l);
        if (osc) inv *= sqrtf(ss_sum(osc, (size_t)(wv * 16 * QT + qt * 16 + i), 16) * (1.0f / 1024) + EPS);
        bf16_t* op = O + (size_t)(wv * 16 * QT + qt * 16 + i) * ldo + quad * 4;
#pragma unroll
        for (int d = 0; d < DT; ++d) { const f32x4 v = acc_o[d][qt] * inv; u32x2 p; p.x = cvt_pk_bf16(v[0], v[1]); p.y = cvt_pk_bf16(v[2], v[3]); *(u32x2*)(op + d * 16) = p; } }
#undef ATT_LOAD
#undef ATT_STORE
#undef ATT_QK
#undef ATT_SOFTMAX_PV
}

__device__ __forceinline__ void xa_item(LAS unsigned char* lds, const bf16_t* Q, const bf16_t* K, const bf16_t* Vt, bf16_t* O) {
    constexpr int KSTR = 264, VSTR = 72, LDQ = 1024, LDK = 1024, LDO = 1024; constexpr long LDV = TMEM;
    LAS bf16_t* Ks = (LAS bf16_t*)lds; LAS bf16_t* Vs = (LAS bf16_t*)lds;
    const int tid = opaque_tid(), lane = tid & 63, wv = tid >> 6, i = lane & 15, quad = lane >> 4;
    bf16x8 qf[2][8];
#pragma unroll
    for (int qt = 0; qt < 2; ++qt)
#pragma unroll
        for (int ks = 0; ks < 8; ++ks) qf[qt][ks] = *(const bf16x8*)(Q + (size_t)(wv * 32 + qt * 16 + i) * LDQ + ks * 32 + quad * 8);
    u32x4 pK[4], pV[2];
    const unsigned koff = (unsigned)((tid >> 5) * LDK + (tid & 31) * 8), voff = (unsigned)((tid >> 3) * LDV + (tid & 7) * 8);
#define XA_LOADK(t_) do { _Pragma("unroll") for (int q = 0; q < 4; ++q) pK[q] = *(const u32x4*)((K + (size_t)((t_) * 64 + q * 16) * LDK) + koff); } while (0)
#define XA_LOADV(h_, t_) do { _Pragma("unroll") for (int q = 0; q < 2; ++q) pV[q] = *(const u32x4*)((Vt + (size_t)((h_) * 128 + q * 64) * LDV + (t_) * 64) + voff); } while (0)
    f32x4 sc[16][2];
#pragma unroll
    for (int k = 0; k < 16; ++k) { sc[k][0] = (f32x4){0.f, 0.f, 0.f, 0.f}; sc[k][1] = (f32x4){0.f, 0.f, 0.f, 0.f}; }
    XA_LOADK(0);
#pragma unroll
    for (int t = 0; t < 4; ++t) {
        __syncthreads();
#pragma unroll
        for (int q = 0; q < 4; ++q) { const int c = tid + q * 512; *(LAS u32x4*)(Ks + (c >> 5) * KSTR + (c & 31) * 8) = pK[q]; }
        __syncthreads();
        if (t < 3) XA_LOADK(t + 1); else XA_LOADV(0, 0);
#pragma unroll
        for (int kt = 0; kt < 4; ++kt)
#pragma unroll
            for (int ks = 0; ks < 8; ++ks) { const bf16x8 kf = ld_frag16(Ks + (kt * 16 + i) * KSTR + ks * 32 + quad * 8);
                sc[t * 4 + kt][0] = MFMA16(kf, qf[0][ks], sc[t * 4 + kt][0]); sc[t * 4 + kt][1] = MFMA16(kf, qf[1][ks], sc[t * 4 + kt][1]); }
    }
    bf16x8 pf[8][2]; float linv[2];
#pragma unroll
    for (int qt = 0; qt < 2; ++qt) {
        float mx = -INFINITY;
#pragma unroll
        for (int k = 0; k < 16; ++k)
#pragma unroll
            for (int j = 0; j < 4; ++j) mx = fmaxf(mx, sc[k][qt][j]);
        mx = fmaxf(mx, shfl_xor_f(mx, 16)); mx = fmaxf(mx, shfl_xor_f(mx, 32));
        float ls = 0.f;
#pragma unroll
        for (int k = 0; k < 16; ++k)
#pragma unroll
            for (int j = 0; j < 4; ++j) { const float p = fexp2(sc[k][qt][j] - mx); sc[k][qt][j] = p; ls += p; }
        ls += shfl_xor_f(ls, 16); ls += shfl_xor_f(ls, 32); linv[qt] = frcp(ls);
#pragma unroll
        for (int u = 0; u < 8; ++u) pf[u][qt] = pack_frag(sc[2 * u][qt], sc[2 * u + 1][qt]);
    }
#pragma unroll
    for (int h = 0; h < 2; ++h) {
        f32x4 acc_o[8][2];
#pragma unroll
        for (int d = 0; d < 8; ++d) { acc_o[d][0] = (f32x4){0.f, 0.f, 0.f, 0.f}; acc_o[d][1] = (f32x4){0.f, 0.f, 0.f, 0.f}; }
#pragma unroll
        for (int t = 0; t < 4; ++t) {
            __syncthreads();
#pragma unroll
            for (int q = 0; q < 2; ++q) { const int c = tid + q * 512; *(LAS u32x4*)(Vs + (c >> 3) * VSTR + (c & 7) * 8) = pV[q]; }
            __syncthreads();
            if (t < 3) XA_LOADV(h, t + 1); else if (h == 0) XA_LOADV(1, 0);
#pragma unroll
            for (int u = 0; u < 2; ++u)
#pragma unroll
                for (int d = 0; d < 8; ++d) { const bf16x8 vf = ld_frag_split(Vs + (d * 16 + i) * VSTR + u * 32 + quad * 4);
                    acc_o[d][0] = MFMA16(vf, pf[t * 2 + u][0], acc_o[d][0]); acc_o[d][1] = MFMA16(vf, pf[t * 2 + u][1], acc_o[d][1]); }
        }
#pragma unroll
        for (int qt = 0; qt < 2; ++qt) { bf16_t* op = O + (size_t)(wv * 32 + qt * 16 + i) * LDO + h * 128 + quad * 4;
#pragma unroll
            for (int d = 0; d < 8; ++d) { const f32x4 v = acc_o[d][qt] * linv[qt]; u32x2 p; p.x = cvt_pk_bf16(v[0], v[1]); p.y = cvt_pk_bf16(v[2], v[3]); *(u32x2*)(op + d * 16) = p; } }
    }
#undef XA_LOADK
#undef XA_LOADV
}

template <int NH>
__device__ __forceinline__ void ssd_item(LAS unsigned char* lds, const Args& a, int e, int b, int g, int hh, int lb, float* ss_g, bool commit) {
    static_assert(NH == 4, "layout below assumes 4 heads per item");
    constexpr int BSTR = 136, XSTR = 72;
    unsigned char* scr = a.ws + OFF_SCR;
    const bf16_t* bcc = (const bf16_t*)(scr + S_BCC); const bf16_t* xT = (const bf16_t*)(scr + S_XT); bf16_t* Z = (bf16_t*)(scr + S_Z);
    const float* cum = (const float*)(scr + S_CUM);
    const float* Dp = (const float*)a.in[21] + e * 16;
    LAS bf16_t* Bs = (LAS bf16_t*)lds; LAS bf16_t* Xs = Bs + 64 * BSTR; LAS float* aFs = (LAS float*)(Xs + NH * 64 * XSTR); LAS float* aBs = aFs + 64 * NH; LAS float* F2 = aBs + 64 * NH;
    const int tid = opaque_tid(), lane = tid & 63, wv = tid >> 6, i = lane & 15, quad = lane >> 4;
    LAS float* F2w = F2 + wv * (64 * NH);
    const int h0 = g * 8 + hh * NH, l0 = lb * 128, lg = l0 + wv * 16 + i, st_d = (l0 + wv * 16) >> 6;
    const size_t trow = (size_t)b * SEQ + lg;
    bf16x8 cf[4];
#pragma unroll
    for (int ks = 0; ks < 4; ++ks) cf[ks] = *(const bf16x8*)(bcc + trow * 512 + 256 + g * 128 + ks * 32 + quad * 8);
    float refF[NH], refB[NH];
    const float* crow = cum + trow * 64 + h0;
#pragma unroll
    for (int r = 0; r < NH; ++r) { const float c = crow[r], ee = crow[32 + r];
        refF[r] = __int_as_float(__builtin_amdgcn_readlane(__float_as_int(c), 0)); refB[r] = __int_as_float(__builtin_amdgcn_readlane(__float_as_int(ee), 15)); }
    f32x4 acc_o[NH][4]; float f1b[NH];
#pragma unroll
    for (int r = 0; r < NH; ++r)
#pragma unroll
        for (int pt = 0; pt < 4; ++pt) acc_o[r][pt] = (f32x4){0.f, 0.f, 0.f, 0.f};
#pragma unroll
    for (int r = 0; r < NH; ++r) f1b[r] = fexp2(refB[r] - crow[32 + r]);
    u32x4 pB[2], pX[4]; float pF = 0.f, pBk = 0.f;
    const bf16_t* bsrc = bcc + ((size_t)b * SEQ) * 512 + g * 128; const bf16_t* xsrc = xT + ((size_t)b * 1024 + h0 * 64) * SEQ;
#define SSD_LOAD(s0_) do { \
        _Pragma("unroll") for (int q = 0; q < 2; ++q) pB[q] = *(const u32x4*)((bsrc + (size_t)((s0_) + q * 32) * 512) + boff); \
        _Pragma("unroll") for (int q = 0; q < 4; ++q) pX[q] = *(const u32x4*)((xsrc + (size_t)q * 64 * SEQ + (s0_)) + xoff); \
        if (tid < 64 * NH) { const float* ap = cum + ((size_t)b * SEQ + (s0_) + (tid >> 2)) * 64 + h0 + (tid & 3); pF = ap[16]; pBk = ap[48]; } } while (0)
    const unsigned boff = (unsigned)((tid >> 4) * 512 + (tid & 15) * 8), xoff = (unsigned)((tid >> 3) * SEQ + (tid & 7) * 8);
    SSD_LOAD(0);
    for (int st = 0; st < SEQ / 64; ++st) {
        const int s0 = st * 64;
        __syncthreads();
#pragma unroll
        for (int q = 0; q < 2; ++q) { const int c = tid + q * 512, s = c >> 4, nc = (c & 15) * 8; *(LAS u32x4*)(Bs + s * BSTR + nc) = pB[q]; }
#pragma unroll
        for (int q = 0; q < 4; ++q) { const int c = tid + q * 512, row = c >> 3, kc = (c & 7) * 8; *(LAS u32x4*)(Xs + row * XSTR + kc) = pX[q]; }
        if (tid < 64 * NH) { aFs[tid] = pF; aBs[tid] = pBk; }
        __syncthreads();
        if (st + 1 < SEQ / 64) SSD_LOAD(s0 + 64);
        f32x4 cb[4];
#pragma unroll
        for (int kt = 0; kt < 4; ++kt) { cb[kt] = (f32x4){0.f, 0.f, 0.f, 0.f};
#pragma unroll
            for (int ks = 0; ks < 4; ++ks) cb[kt] = MFMA16(ld_frag16(Bs + (kt * 16 + i) * BSTR + ks * 32 + quad * 8), cf[ks], cb[kt]); }
        if (st == st_d) {
#pragma unroll
            for (int r = 0; r < NH; ++r) { const float f1 = fexp2(crow[r] - refF[r]);
#pragma unroll
                for (int pt = 0; pt < 4; ++pt) acc_o[r][pt] *= f1; }
#pragma unroll
            for (int r = 0; r < NH; ++r) {
                const float clr = crow[r], elr = crow[32 + r], ddr = Dp[h0 + r];
                f32x4 w[4];
#pragma unroll
                for (int kt = 0; kt < 4; ++kt)
#pragma unroll
                    for (int j = 0; j < 4; ++j) { const int sl = kt * 16 + quad * 4 + j, sg = s0 + sl; const float af = aFs[sl * NH + r], ab = aBs[sl * NH + r];
                        const float argf = clr - af, argb = ab - elr;
                        float v;
                        if (sg == lg) v = cb[kt][j] * (fexp2(argf) + fexp2(argb)) + ddr;
                        else v = cb[kt][j] * fexp2(sg < lg ? argf : argb);
                        w[kt][j] = v; }
                const bf16x8 p0 = pack_frag(w[0], w[1]), p1 = pack_frag(w[2], w[3]);
#pragma unroll
                for (int pt = 0; pt < 4; ++pt) {
                    acc_o[r][pt] = MFMA16(ld_frag_split(Xs + (r * 64 + pt * 16 + i) * XSTR + quad * 4), p0, acc_o[r][pt]);
                    acc_o[r][pt] = MFMA16(ld_frag_split(Xs + (r * 64 + pt * 16 + i) * XSTR + 32 + quad * 4), p1, acc_o[r][pt]); }
            }
        } else {
            const bool lower = st < st_d;
            { const f32x4 av = lower ? *(const LAS f32x4*)(aFs + lane * NH) : *(const LAS f32x4*)(aBs + lane * NH);
#pragma unroll
              for (int r = 0; r < NH; ++r) F2w[r * 64 + lane] = lower ? fexp2(refF[r] - av[r]) : fexp2(av[r] - refB[r]); }
            asm volatile("s_waitcnt lgkmcnt(0)" ::: "memory");
#define SSD_OFFDIAG(ACC, F1) do { _Pragma("unroll") for (int r = 0; r < NH; ++r) { bf16x8 p0, p1; \
                { const f32x4 w0 = cb[0] * *(const LAS f32x4*)(F2w + r * 64 + quad * 4) F1, w1 = cb[1] * *(const LAS f32x4*)(F2w + r * 64 + 16 + quad * 4) F1; p0 = pack_frag(w0, w1); } \
                { const f32x4 w2 = cb[2] * *(const LAS f32x4*)(F2w + r * 64 + 32 + quad * 4) F1, w3 = cb[3] * *(const LAS f32x4*)(F2w + r * 64 + 48 + quad * 4) F1; p1 = pack_frag(w2, w3); } \
                _Pragma("unroll") for (int pt = 0; pt < 4; ++pt) { \
                    ACC[r][pt] = MFMA16(ld_frag_split(Xs + (r * 64 + pt * 16 + i) * XSTR + quad * 4), p0, ACC[r][pt]); \
                    ACC[r][pt] = MFMA16(ld_frag_split(Xs + (r * 64 + pt * 16 + i) * XSTR + 32 + quad * 4), p1, ACC[r][pt]); } } } while (0)
            if (lower) SSD_OFFDIAG(acc_o, ); else SSD_OFFDIAG(acc_o, * f1b[r]);
#undef SSD_OFFDIAG
        }
    }
#undef SSD_LOAD
    float ss = 0.f;
#pragma unroll
    for (int r = 0; r < NH; ++r) {
#pragma unroll
        for (int pt = 0; pt < 4; ++pt) { const f32x4 yv = acc_o[r][pt];
            bf16_t* zp = Z + trow * 1024 + (h0 + r) * 64 + pt * 16 + quad * 4; const u32x2 zv = *(const u32x2*)zp;
            const float y0 = yv[0] * silu_f(bflo(zv.x)), y1 = yv[1] * silu_f(bfhi(zv.x)), y2 = yv[2] * silu_f(bflo(zv.y)), y3 = yv[3] * silu_f(bfhi(zv.y));
            ss += y0 * y0 + y1 * y1 + y2 * y2 + y3 * y3; u32x2 o; o.x = cvt_pk_bf16(y0, y1); o.y = cvt_pk_bf16(y2, y3); if (commit) *(u32x2*)zp = o; } }
    ss += shfl_xor_f(ss, 16); ss += shfl_xor_f(ss, 32);
    if (quad == 0 && commit) { float* gp = ss_g + trow * 16 + g * 2 + hh; gp[0] = ss; gp[4] = 0.f; gp[8] = 0.f; gp[12] = 0.f; }
}

__device__ __forceinline__ void ssd_item2(LAS unsigned char* lds, const Args& a, int e, int b, int g, int hq, int lb, float* ss_g, bool commit) {
    constexpr int NH = 2, BSTR = 136, XSTR = 72;
    unsigned char* scr = a.ws + OFF_SCR;
    const bf16_t* bcc = (const bf16_t*)(scr + S_BCC); const bf16_t* xT = (const bf16_t*)(scr + S_XT); bf16_t* Z = (bf16_t*)(scr + S_Z);
    const float* cum = (const float*)(scr + S_CUM);
    const float* Dp = (const float*)a.in[21] + e * 16;
    LAS bf16_t* Bs = (LAS bf16_t*)lds; LAS bf16_t* Xs = Bs + 64 * BSTR; LAS float* aFs = (LAS float*)(Xs + NH * 64 * XSTR); LAS float* aBs = aFs + 64 * NH; LAS float* F2 = aBs + 64 * NH;
    const int tid = opaque_tid(), lane = tid & 63, wv = tid >> 6, i = lane & 15, quad = lane >> 4;
    LAS float* F2w = F2 + wv * (64 * NH);
    const int h0 = g * 8 + hq * NH, l0 = lb * 256 + wv * 32, st_d = l0 >> 6;
    const size_t trow0 = (size_t)b * SEQ + l0 + i;
    bf16x8 cf[2][4];
#pragma unroll
    for (int qt = 0; qt < 2; ++qt)
#pragma unroll
        for (int ks = 0; ks < 4; ++ks) cf[qt][ks] = *(const bf16x8*)(bcc + (trow0 + 16 * qt) * 512 + 256 + g * 128 + ks * 32 + quad * 8);
    const float* crow = cum + trow0 * 64 + h0;
    float refF[NH], refB[NH], f1b[2][NH];
#pragma unroll
    for (int r = 0; r < NH; ++r) { const float c = crow[r], ee = crow[16 * 64 + 32 + r];
        refF[r] = __int_as_float(__builtin_amdgcn_readlane(__float_as_int(c), 0)); refB[r] = __int_as_float(__builtin_amdgcn_readlane(__float_as_int(ee), 15));
        f1b[0][r] = fexp2(refB[r] - crow[32 + r]); f1b[1][r] = fexp2(refB[r] - ee); }
    f32x4 acc_o[NH][4][2];
#pragma unroll
    for (int r = 0; r < NH; ++r)
#pragma unroll
        for (int pt = 0; pt < 4; ++pt) { acc_o[r][pt][0] = (f32x4){0.f, 0.f, 0.f, 0.f}; acc_o[r][pt][1] = (f32x4){0.f, 0.f, 0.f, 0.f}; }
    u32x4 pB[2], pX[2]; float pF = 0.f, pBk = 0.f;
    const bf16_t* bsrc = bcc + ((size_t)b * SEQ) * 512 + g * 128; const bf16_t* xsrc = xT + ((size_t)b * 1024 + h0 * 64) * SEQ;
    const unsigned boff = (unsigned)((tid >> 4) * 512 + (tid & 15) * 8), xoff = (unsigned)((tid >> 3) * SEQ + (tid & 7) * 8);
#define SSD_LOAD(s0_) do { \
        _Pragma("unroll") for (int q = 0; q < 2; ++q) pB[q] = *(const u32x4*)((bsrc + (size_t)((s0_) + q * 32) * 512) + boff); \
        _Pragma("unroll") for (int q = 0; q < 2; ++q) pX[q] = *(const u32x4*)((xsrc + (size_t)q * 64 * SEQ + (s0_)) + xoff); \
        if (tid < 64 * NH) { const float* ap = cum + ((size_t)b * SEQ + (s0_) + (tid >> 1)) * 64 + h0 + (tid & 1); pF = ap[16]; pBk = ap[48]; } } while (0)
    SSD_LOAD(0);
    for (int st = 0; st < SEQ / 64; ++st) {
        const int s0 = st * 64;
        __syncthreads();
#pragma unroll
        for (int q = 0; q < 2; ++q) { const int c = tid + q * 512, s = c >> 4, nc = (c & 15) * 8; *(LAS u32x4*)(Bs + s * BSTR + nc) = pB[q]; }
#pragma unroll
        for (int q = 0; q < 2; ++q) { const int c = tid + q * 512, row = c >> 3, kc = (c & 7) * 8; *(LAS u32x4*)(Xs + row * XSTR + kc) = pX[q]; }
        if (tid < 64 * NH) { aFs[tid] = pF; aBs[tid] = pBk; }
        __syncthreads();
        if (st + 1 < SEQ / 64) SSD_LOAD(s0 + 64);
        const bool diag = (st == st_d), lower = st < st_d; bool live0 = true, live1 = true;
        if (diag) {
#pragma unroll
            for (int r = 0; r < NH; ++r)
#pragma unroll
                for (int qt = 0; qt < 2; ++qt) { const float f1 = fexp2(crow[qt * 16 * 64 + r] - refF[r]);
#pragma unroll
                    for (int pt = 0; pt < 4; ++pt) acc_o[r][pt][qt] *= f1; }
        } else {
            const float av0 = lower ? aFs[lane * NH] : aBs[lane * NH], av1 = lower ? aFs[lane * NH + 1] : aBs[lane * NH + 1];
            const float f20 = lower ? fexp2(refF[0] - av0) : fexp2(av0 - refB[0]), f21 = lower ? fexp2(refF[1] - av1) : fexp2(av1 - refB[1]);
            F2w[lane] = f20; F2w[64 + lane] = f21;
            live0 = __builtin_amdgcn_ballot_w64(f20 != 0.f) != 0ull; live1 = __builtin_amdgcn_ballot_w64(f21 != 0.f) != 0ull;
            asm volatile("s_waitcnt lgkmcnt(0)" ::: "memory");
        }
        if (live0 || live1) {
#pragma unroll
        for (int u = 0; u < 2; ++u) {
            f32x4 cb[2][2];
#pragma unroll
            for (int kk = 0; kk < 2; ++kk) { cb[kk][0] = (f32x4){0.f, 0.f, 0.f, 0.f}; cb[kk][1] = (f32x4){0.f, 0.f, 0.f, 0.f};
#pragma unroll
                for (int ks = 0; ks < 4; ++ks) { const bf16x8 bf = ld_frag16(Bs + ((2 * u + kk) * 16 + i) * BSTR + ks * 32 + quad * 8);
                    cb[kk][0] = MFMA16(bf, cf[0][ks], cb[kk][0]); cb[kk][1] = MFMA16(bf, cf[1][ks], cb[kk][1]); } }
#pragma unroll
            for (int r = 0; r < NH; ++r) {
                if (!(r == 0 ? live0 : live1)) continue;
                bf16x8 p[2];
                if (diag) {
                    const float ddr = Dp[h0 + r];
#pragma unroll
                    for (int qt = 0; qt < 2; ++qt) { const float clr = crow[qt * 16 * 64 + r], elr = crow[qt * 16 * 64 + 32 + r]; const int lg = l0 + 16 * qt + i; f32x4 w[2];
#pragma unroll
                        for (int kk = 0; kk < 2; ++kk)
#pragma unroll
                            for (int j = 0; j < 4; ++j) { const int sl = (2 * u + kk) * 16 + quad * 4 + j, sg = s0 + sl; const float af = aFs[sl * NH + r], ab = aBs[sl * NH + r];
                                const float argf = clr - af, argb = ab - elr; float v;
                                if (sg == lg) v = cb[kk][qt][j] * (fexp2(argf) + fexp2(argb)) + ddr;
                                else v = cb[kk][qt][j] * fexp2(sg < lg ? argf : argb);
                                w[kk][j] = v; }
                        p[qt] = pack_frag(w[0], w[1]); }
                } else {
                    const f32x4 fa = *(const LAS f32x4*)(F2w + r * 64 + u * 32 + quad * 4), fb = *(const LAS f32x4*)(F2w + r * 64 + u * 32 + 16 + quad * 4);
#pragma unroll
                    for (int qt = 0; qt < 2; ++qt) { const float fs = lower ? 1.0f : f1b[qt][r]; p[qt] = pack_frag(cb[0][qt] * fa * fs, cb[1][qt] * fb * fs); }
                }
#pragma unroll
                for (int pt = 0; pt < 4; ++pt) { const bf16x8 xf = ld_frag_split(Xs + (r * 64 + pt * 16 + i) * XSTR + u * 32 + quad * 4);
                    acc_o[r][pt][0] = MFMA16(xf, p[0], acc_o[r][pt][0]); acc_o[r][pt][1] = MFMA16(xf, p[1], acc_o[r][pt][1]); }
            }
        }
        }
    }
#undef SSD_LOAD
#pragma unroll
    for (int qt = 0; qt < 2; ++qt) { float ss = 0.f; const size_t trow = trow0 + 16 * qt;
#pragma unroll
        for (int r = 0; r < NH; ++r)
#pragma unroll
            for (int pt = 0; pt < 4; ++pt) { const f32x4 yv = acc_o[r][pt][qt];
                bf16_t* zp = Z + trow * 1536 + (h0 + r) * 64 + pt * 16 + quad * 4; const u32x2 zv = *(const u32x2*)zp;
                const float y0 = yv[0] * silu_f(bflo(zv.x)), y1 = yv[1] * silu_f(bfhi(zv.x)), y2 = yv[2] * silu_f(bflo(zv.y)), y3 = yv[3] * silu_f(bfhi(zv.y));
                ss += y0 * y0 + y1 * y1 + y2 * y2 + y3 * y3; u32x2 o; o.x = cvt_pk_bf16(y0, y1); o.y = cvt_pk_bf16(y2, y3); if (commit) *(u32x2*)zp = o; }
        ss += shfl_xor_f(ss, 16); ss += shfl_xor_f(ss, 32);
        if (quad == 0 && commit) { float* gp = ss_g + trow * 16 + g * 4 + hq; gp[0] = ss; gp[8] = 0.f; } }
}

__device__ void fnet_norm_T(const Args& a, int l, const float* rss, LAS unsigned char* lds) {
    const float* h = a.out; const float* w = (const float*)a.in[8] + l * DM; bf16_t* uT = (bf16_t*)(a.ws + OFF_SCR + S_UT);
    LAS bf16_t* tl = (LAS bf16_t*)lds; const int tid = opaque_tid();
    for (int trip = 0; ; ++trip) { const int it = xcd_item(trip, NB * 32 * 4); if (it < 0) break;
        const int b = it >> 7, st = (it >> 2) & 31, ct = it & 3, s0 = st * 64, c0 = ct * 256;
        { const int s = tid >> 3, cv = tid & 7; const size_t row = (size_t)b * SEQ + s0 + s;
          const float rs = rstd_of(ss_sum(rss, row, 16), 1.0f / DM);
          f32x4 v0[4], v1[4];
#pragma unroll
          for (int j = 0; j < 4; ++j) { const int ch = c0 + 64 * j + 8 * cv; v0[j] = *(const f32x4*)(h + row * DM + ch); v1[j] = *(const f32x4*)(h + row * DM + ch + 4); }
#pragma unroll
          for (int j = 0; j < 4; ++j) { const int ch = c0 + 64 * j + 8 * cv; const f32x4 w0 = *(const f32x4*)(w + ch), w1 = *(const f32x4*)(w + ch + 4);
              const f32x4 r0 = v0[j] * w0 * rs, r1 = v1[j] * w1 * rs;
              const unsigned p0 = cvt_pk_bf16(r0[0], r0[1]), p1 = cvt_pk_bf16(r0[2], r0[3]), p2 = cvt_pk_bf16(r1[0], r1[1]), p3 = cvt_pk_bf16(r1[2], r1[3]);
              LAS bf16_t* tp = tl + (64 * j + 8 * cv) * 72 + s;
              tp[0] = (bf16_t)(p0 & 0xffff); tp[72] = (bf16_t)(p0 >> 16); tp[144] = (bf16_t)(p1 & 0xffff); tp[216] = (bf16_t)(p1 >> 16);
              tp[288] = (bf16_t)(p2 & 0xffff); tp[360] = (bf16_t)(p2 >> 16); tp[432] = (bf16_t)(p3 & 0xffff); tp[504] = (bf16_t)(p3 >> 16); } }
        __syncthreads();
        { const int sv = tid & 7;
#pragma unroll
          for (int j = 0; j < 4; ++j) { const int ch = (tid >> 3) + 64 * j; const u32x4 v = *(const LAS u32x4*)(tl + ch * 72 + 8 * sv);
              *(u32x4*)(uT + ((size_t)b * 1024 + c0 + ch) * SEQ + s0 + 8 * sv) = v; } }
        __syncthreads();
    }
}
__device__ void final_norm(const Args& a, const float* rss) {
    const float* w = (const float*)a.in[4]; const int tid = opaque_tid(); const int lane = tid & 63, wv = tid >> 6;
    for (int rl = (int)(blockIdx.x >> 3) * 8 + wv; rl < T_TOK / 8; rl += (int)(gridDim.x >> 3) * 8) { const int r = (int)(blockIdx.x & 7) * (T_TOK / 8) + rl;
        const float rs = rstd_of(ss_sum(rss, (size_t)r, 16), 1.0f / DM); float* p = a.out + (size_t)r * DM + lane * 4;
#pragma unroll
        for (int k = 0; k < 4; ++k) { const f32x4 v = *(const f32x4*)(p + k * 256), wv4 = *(const f32x4*)(w + lane * 4 + k * 256); *(f32x4*)(p + k * 256) = v * wv4 * rs; }
    }
}


#define XB_TMO      128
#define XB_XCNT(j)  (256  + 64 * (j))
#define XB_XSUB(j)  (1280 + 64 * (j))
#define XB_XGEN(j)  (2304 + 64 * (j))
#define XB_TOP      3328
#define XB_TOPGEN   3392
#define XCD_BAR_WORDS 3456
#define XB_SPIN_CAP (1u << 18)
__device__ __forceinline__ unsigned xb_ld(unsigned* p)              { return __hip_atomic_load(p, __ATOMIC_RELAXED, __HIP_MEMORY_SCOPE_AGENT); }
__device__ __forceinline__ unsigned xb_add(unsigned* p, unsigned v) { return __hip_atomic_fetch_add(p, v, __ATOMIC_RELAXED, __HIP_MEMORY_SCOPE_AGENT); }
__device__ __forceinline__ unsigned xb_xcc_id() { return (unsigned)__builtin_amdgcn_s_getreg((3 << 11) | 20) & 0xFu; }
#define XB_SPIN(cond, bar) do { unsigned _sp = 0; while (cond) { __builtin_amdgcn_s_sleep(1); \
    if ((++_sp & 255u) == 0u) { if (xb_ld(&(bar)[XB_TMO])) break; if (_sp > XB_SPIN_CAP) { atomicAdd(&(bar)[XB_TMO], 1u); break; } } } } while (0)
struct XcdBarrier { unsigned* bar; unsigned x; volatile LAS unsigned* st; };
__device__ __forceinline__ XcdBarrier xcd_barrier_post(unsigned* bar, volatile LAS unsigned* st) {
    XcdBarrier b; b.bar = bar; b.x = xb_xcc_id(); b.st = st;
    if (threadIdx.x == 0) (void)xb_add(&bar[XB_XCNT(b.x)], 1u);
    return b;
}
__device__ __forceinline__ void xcd_barrier_complete(unsigned* bar, unsigned x, unsigned& nloc, unsigned& nx) {
    const unsigned G = gridDim.x * gridDim.y * gridDim.z;
    unsigned sum, cnt, mine, sp = 0u;
    for (;;) {
        sum = 0u; cnt = 0u; mine = 0u;
#pragma unroll
        for (unsigned j = 0; j < 16; ++j) { const unsigned c = xb_ld(&bar[XB_XCNT(j)]); sum += c; cnt += (c > 0u) ? 1u : 0u; mine = (j == x) ? c : mine; }
        if (sum == G) break;
        __builtin_amdgcn_s_sleep(1);
        if ((++sp & 255u) == 0u) { if (xb_ld(&bar[XB_TMO])) break; if (sp > XB_SPIN_CAP) { atomicAdd(&bar[XB_TMO], 1u); break; } }
    }
    nloc = mine > 0u ? mine : 1u; nx = cnt > 0u ? cnt : 1u;
}
__device__ __forceinline__ void xcd_barrier(const XcdBarrier& b) {
    asm volatile("s_waitcnt vmcnt(0)" ::: "memory");
    __syncthreads();
    if (threadIdx.x == 0) {
        unsigned* bar = b.bar;
        __builtin_amdgcn_s_waitcnt(0);
        unsigned nloc = b.st[0], nx = b.st[1];
        if (nloc == 0u) { xcd_barrier_complete(bar, b.x, nloc, nx); b.st[0] = nloc; b.st[1] = nx; }
        const unsigned old = xb_add(&bar[XB_XSUB(b.x)], 1u);
        const unsigned gen = old / nloc;
        if (old + 1u == (gen + 1u) * nloc) {
            __builtin_amdgcn_fence(__ATOMIC_RELEASE, "agent");
            asm volatile("s_waitcnt vmcnt(0)" ::: "memory");
            const unsigned og = xb_add(&bar[XB_TOP], 1u);
            const unsigned tg = og / nx;
            if (og + 1u == (tg + 1u) * nx) xb_add(&bar[XB_TOPGEN], 1u);
            else XB_SPIN(xb_ld(&bar[XB_TOPGEN]) == tg, bar);
            __builtin_amdgcn_fence(__ATOMIC_ACQUIRE, "agent");
            xb_add(&bar[XB_XGEN(b.x)], 1u);
            asm volatile("s_waitcnt vmcnt(0)" ::: "memory");
        } else {
            XB_SPIN(xb_ld(&bar[XB_XGEN(b.x)]) == gen, bar);
            __builtin_amdgcn_fence(__ATOMIC_ACQUIRE, "agent");
            asm volatile("s_waitcnt vmcnt(0)" ::: "memory");
        }
    }
    __syncthreads();
}

enum { PT_INIT = 0, PT_CONVERT, PT_FFN1A, PT_FFN1B, PT_E1, PT_E2, PT_E3, PT_E4, PT_E5, PT_O1, PT_O2, PT_O3, PT_X1, PT_X2, PT_X3, PT_FFN2A, PT_FFN2B, PT_FINAL };
enum { EK_NONE = -1, EK_SWIGLU = 0, EK_RESID, EK_STORE, EK_STORE_ROPE, EK_STORE_DFT, EK_WIN };
#ifndef DUP_MASK
#define DUP_MASK 0
#endif
#define PH(t, l) {t, l},
#define PHD(t, l) {t, l}, {(unsigned char)(((DUP_MASK >> (t)) & 1) ? (t) : 99), (unsigned char)((l) | 128)},
#define LAYER_EVEN(l) PHD(PT_FFN1A, l) PHD(PT_FFN1B, l) PHD(PT_E1, l) PHD(PT_E2, l) PHD(PT_E3, l) PHD(PT_E4, l) PHD(PT_E5, l) PHD(PT_X1, l) PHD(PT_X2, l) PHD(PT_X3, l) PHD(PT_FFN2A, l) PHD(PT_FFN2B, l)
#define LAYER_ODD(l) PHD(PT_FFN1A, l) PHD(PT_FFN1B, l) PHD(PT_O1, l) PHD(PT_O2, l) PHD(PT_O3, l) PHD(PT_X1, l) PHD(PT_X2, l) PHD(PT_X3, l) PHD(PT_FFN2A, l) PHD(PT_FFN2B, l)
#if DUP_MASK
__constant__ unsigned char PROG[][2] = { PH(PT_INIT, 0) LAYER_EVEN(0) PHD(PT_CONVERT, 1) LAYER_ODD(1) PHD(PT_CONVERT, 2) LAYER_EVEN(2) PHD(PT_CONVERT, 3) LAYER_ODD(3) PH(PT_FINAL, 0) };
#else
#undef PHD
#define PHD(t, l) {t, l},
__constant__ unsigned char PROG[][2] = { PH(PT_INIT, 0) LAYER_EVEN(0) PHD(PT_CONVERT, 1) LAYER_ODD(1) PHD(PT_CONVERT, 2) LAYER_EVEN(2) PHD(PT_CONVERT, 3) LAYER_ODD(3) PH(PT_FINAL, 0) };
#endif
constexpr int N_PHASES = (int)(sizeof(PROG) / 2);

struct EP { bf16_t* out; long ldc; const float* hin; bf16_t* hb; float* ss_out; const float* rss; int rss_w; float rs_inv; const float* css; int css_w; float cs_inv; long zoff; float alpha; };

__device__ __forceinline__ int build_job(const Args& a, int type, int l, int j, Gemm& g, EP& ep) {
    unsigned char* ws = a.ws; unsigned char* scr = ws + OFF_SCR;
    bf16_t* wb = (bf16_t*)(ws + OFF_WB); bf16_t* hb = (bf16_t*)(ws + OFF_HB);
    float* rowss = (float*)(ws + OFF_ROWSS); float* memss = (float*)(ws + OFF_MEMSS);
    float* h0 = rowss + RS_H0; float* h1 = rowss + RS_H1;
    float* ss_cq = rowss + RS_CQ; float* ss_ckv = rowss + RS_CKV; float* ss_g = rowss + RS_G;
    ep.out = nullptr; ep.ldc = 0; ep.hin = a.out; ep.hb = nullptr; ep.ss_out = nullptr; ep.rss = nullptr; ep.rss_w = 16; ep.rs_inv = 0.f; ep.css = nullptr; ep.css_w = 1; ep.cs_inv = 0.f; ep.zoff = 0; ep.alpha = 1.0f;
    switch (type) {
    case PT_FFN1A: case PT_FFN2A:
        if (j == 0) { g = mk_gemm(hb, DM, wb + (type == PT_FFN1A ? W_GU1 : W_GU2), DM, DM, 128, 22); ep.out = (bf16_t*)(scr + S_ACT); ep.rss = (type == PT_FFN1A ? h0 : h1); return EK_SWIGLU; }
        if (j == 1 && type == PT_FFN1A && (l & 1)) {
            g = mk_gemm(wb + W_FT, DM, (const bf16_t*)(ws + OFF_TCH), 256, 256, 4, 1); g.nZ = 8; g.zd = 4; g.sA1 = 0; g.sA2 = 256; g.sB1 = 65536; g.sB2 = 0;
            ep.out = wb + W_FOLD; ep.ldc = 2048; ep.zoff = 256; return EK_STORE; }
        return EK_NONE;
    case PT_FFN1B: case PT_FFN2B:
        if (j == 0) { g = mk_gemm((const bf16_t*)(scr + S_ACT), DFF, wb + (type == PT_FFN1B ? W_DN1 : W_DN2), DFF, DFF, 128, 4);
            ep.hin = (type == PT_FFN1B && l == 0) ? (const float*)a.in[0] : a.out; ep.hb = hb; ep.ss_out = (type == PT_FFN1B ? h1 : h0); ep.alpha = 0.5f; return EK_RESID; }
        return EK_NONE;
    case PT_E1:
        if (j == 0) { g = mk_gemm(hb, DM, wb + W_IN, DM, DM, 128, 14); ep.rss = h1; ep.ss_out = ss_cq; ep.css = ss_ckv; return EK_WIN; }
        return EK_NONE;
    case PT_E3:
        if (j == 0) { g = mk_gemm((const bf16_t*)(scr + S_CQ), 512, wb + W_UQ, 512, 512, 128, 3); ep.out = (bf16_t*)(scr + S_QB); ep.ldc = 768; ep.rss = ss_cq; ep.rss_w = 8; ep.rs_inv = 1.0f / 512; return EK_STORE_ROPE; }
        if (j == 1) { g = mk_gemm((const bf16_t*)(scr + S_CKV), 256, wb + W_KN, 256, 256, 128, 2); ep.out = (bf16_t*)(scr + S_KN); ep.ldc = 512; ep.rss = ss_ckv; ep.rss_w = 4; ep.rs_inv = 1.0f / 256; return EK_STORE; }
        if (j == 2) { g = mk_gemm(wb + W_VV, 256, (const bf16_t*)(scr + S_CKV), 256, 256, 2, 128); ep.out = hb; ep.ldc = T_TOK; ep.css = ss_ckv; ep.css_w = 4; ep.cs_inv = 1.0f / 256; return EK_STORE; }
        return EK_NONE;
    case PT_E5:
        if (j == 0) { g = mk_gemm((const bf16_t*)(scr + S_Z), 1536, wb + W_OY, 1536, 1536, 128, 4); ep.rss = ss_g; ep.rss_w = 4; ep.rs_inv = 1.0f / 1024; ep.hb = hb; ep.ss_out = h0; return EK_RESID; }
        return EK_NONE;
    case PT_O2:
        if (j == 0) { g = mk_gemm((const bf16_t*)(ws + OFF_FSEQ), 2048, (const bf16_t*)(scr + S_UT), 2048, 2048, 8, 64); ep.out = (bf16_t*)(scr + S_YCS); ep.ldc = 2048; return EK_STORE_DFT; }
        return EK_NONE;
    case PT_O3:
        if (j == 0) { g = mk_gemm((const bf16_t*)(scr + S_YCS), 2048, wb + W_FOLD, 2048, 2048, 128, 4); ep.hb = hb; ep.ss_out = h0; return EK_RESID; }
        return EK_NONE;
    case PT_X1:
        if (j == 0) { g = mk_gemm(hb, DM, wb + W_Q, DM, DM, 128, 4); ep.out = (bf16_t*)(scr + S_XQ); ep.ldc = 1024; ep.rss = h0; ep.rs_inv = 1.0f / DM; return EK_STORE; }
        if (j == 1) { g = mk_gemm((const bf16_t*)(ws + OFF_MEMB), DM, wb + W_K, DM, DM, 16, 4); g.rot = 128; ep.out = (bf16_t*)(ws + OFF_KMEM); ep.ldc = 1024; ep.rss = memss; ep.rss_w = 1; ep.rs_inv = 1.0f / DM; return EK_STORE; }
        if (j == 2) { g = mk_gemm(wb + W_V, DM, (const bf16_t*)(ws + OFF_MEMB), DM, DM, 4, 16); g.rot = 64; ep.out = (bf16_t*)(ws + OFF_VTM); ep.ldc = TMEM; ep.css = memss; ep.cs_inv = 1.0f / DM; return EK_STORE; }
        return EK_NONE;
    case PT_X3:
        if (j == 0) { g = mk_gemm((const bf16_t*)(scr + S_XO), DM, wb + W_O, DM, DM, 128, 4); ep.hb = hb; ep.ss_out = h1; return EK_RESID; }
        return EK_NONE;
    default: return EK_NONE;
    }
}

__global__ void __launch_bounds__(512, 2) mk_fwd(Args a) {
    extern __shared__ __attribute__((aligned(16))) unsigned char shm[];
    LAS unsigned char* lds = (LAS unsigned char*)shm;
    unsigned char* ws = a.ws; unsigned char* scr = ws + OFF_SCR;
    const int* pos = (const int*)a.in[2];
    LAS unsigned* xst = (LAS unsigned*)(lds + LDS_XST);
    if (threadIdx.x == 0) { xst[0] = 0u; xst[1] = 0u; }
    __syncthreads();
    const XcdBarrier xb = xcd_barrier_post((unsigned*)(ws + OFF_BAR), (volatile LAS unsigned*)xst);
    for (int ph = a.ph_lo; ph < a.ph_hi && ph < N_PHASES; ++ph) {
        int type = PROG[ph][0]; const int l = PROG[ph][1] & 3, e = l >> 1; const bool dup = (PROG[ph][1] & 128) != 0;
#ifdef DBG_LAYERS
        if (l >= DBG_LAYERS && type != PT_FINAL) type = 99;
#endif
#ifdef DBG_SKIP_MIX
        if (type >= PT_E1 && type <= PT_O3) type = 99;
#endif
#ifdef DBG_SKIP_XA
        if (type >= PT_X1 && type <= PT_X3) type = 99;
#endif
        if (type == 99) continue;
        float* rowss = (float*)(ws + OFF_ROWSS);
        for (int j = 0; j < 3; ++j) {
            Gemm g; EP ep; const int ek = build_job(a, type, l, j, g, ep);
            if (ek == EK_NONE) break;
            if (dup) { ep.alpha = 0.f; ep.hin = a.out; }
            LAS float* rsc = (LAS float*)(lds + LDS_RSC) + threadIdx.x * 9; rsc[0] = __int_as_float(-1);
            switch (ek) {
            case EK_SWIGLU: { EpiSwiglu E; E.rsc = rsc; E.act = ep.out; E.rss = ep.rss; E.rss_w = ep.rss_w; gemm_phase(lds, g, E); } break;
            case EK_RESID: { EpiResid E; E.rsc = rsc; E.hin = ep.hin; E.hout = a.out; E.hb = ep.hb; E.ss_out = ep.ss_out; E.rss = ep.rss; E.rss_w = ep.rss_w; E.rss_inv_dim = ep.rs_inv; E.alpha = ep.alpha; gemm_phase(lds, g, E); } break;
            case EK_STORE: { EpiStore<0, false> E; E.rsc = rsc; E.out = ep.out; E.ldc = ep.ldc; E.rss = ep.rss; E.rss_w = ep.rss_w; E.rs_inv_dim = ep.rs_inv; E.css = ep.css; E.css_w = ep.css_w; E.cs_inv_dim = ep.cs_inv; E.zoff = ep.zoff; E.pos = nullptr; gemm_phase(lds, g, E); } break;
            case EK_STORE_ROPE: { EpiStore<0, true> E; E.rsc = rsc; E.out = ep.out; E.ldc = ep.ldc; E.rss = ep.rss; E.rss_w = ep.rss_w; E.rs_inv_dim = ep.rs_inv; E.css = nullptr; E.css_w = 1; E.cs_inv_dim = 0.f; E.zoff = 0; E.pos = pos; gemm_phase(lds, g, E); } break;
            case EK_STORE_DFT: { EpiStore<1, false> E; E.rsc = rsc; E.out = ep.out; E.ldc = ep.ldc; E.rss = nullptr; E.rss_w = 1; E.css_w = 1; E.rs_inv_dim = 0.f; E.css = nullptr; E.cs_inv_dim = 0.f; E.zoff = 0; E.pos = nullptr; gemm_phase(lds, g, E); } break;
            default: { EpiWin E; E.rsc = rsc; E.scr = scr; E.rss = ep.rss; E.rss_w = ep.rss_w; E.ss_cq = ep.ss_out; E.ss_ckv = (float*)ep.css; E.pos = pos; gemm_phase(lds, g, E); } break;
            }
        }
        switch (type) {
        case PT_INIT:
            rows_to_bf16((const float*)a.in[0], (bf16_t*)(ws + OFF_HB), rowss + RS_H0, T_TOK, 16);
            rows_to_bf16((const float*)a.in[1], (bf16_t*)(ws + OFF_MEMB), (float*)(ws + OFF_MEMSS), TMEM, 16);
            gen_tables(a);
            convert_layer(a, 0, (LAS float*)lds);
            break;
        case PT_CONVERT: convert_layer(a, l, (LAS float*)lds); break;
        case PT_E2: conv_phase(a, e, lds); break;
        case PT_E3:
            for (int trip = 0; ; ++trip) { const int it = xcd_item(trip, NB * 2 * 4 * 8); if (it < 0) break; const int b = it >> 6, g = (it >> 5) & 1, hq = (it >> 3) & 3, lb = it & 7;
                ssd_item2(lds, a, e, b, g, hq, lb, rowss + RS_G, !dup); }
            break;
        case PT_E4:
            for (int trip = 0; ; ++trip) { const int it = xcd_item(trip, NB * 8 * 8); if (it < 0) break; const int b = it >> 6, hd = (it >> 3) & 7, qb = it & 7; const size_t r0 = (size_t)b * SEQ;
                attn_item<96, 64, 64, 2, 2>(lds, (const bf16_t*)(scr + S_QB) + (r0 + qb * 256) * 768 + hd * 96, 768,
                    (const bf16_t*)(scr + S_KN) + r0 * 512 + hd * 64, 512, (const bf16_t*)(scr + S_KROPE) + r0 * 32, 32,
                    (const bf16_t*)(ws + OFF_HB) + (size_t)(hd * 64) * T_TOK + r0, T_TOK, SEQ, (bf16_t*)(scr + S_Z) + (r0 + qb * 256) * 1536 + 1024 + hd * 64, 1536, rowss + RS_G + (r0 + qb * 256) * 16); }
            break;
        case PT_O1: fnet_norm_T(a, l, rowss + RS_H1, lds); break;
        case PT_X2:
            for (int trip = 0; ; ++trip) { const int it = xcd_item(trip, NB * 4 * 8); if (it < 0) break; const int b = it >> 5, hd = (it >> 3) & 3, qb = it & 7; const size_t r0 = (size_t)b * SEQ + qb * 256;
                xa_item(lds, (const bf16_t*)(scr + S_XQ) + r0 * 1024 + hd * 256, (const bf16_t*)(ws + OFF_KMEM) + (size_t)(b * NMEM) * 1024 + hd * 256,
                    (const bf16_t*)(ws + OFF_VTM) + (size_t)(hd * 256) * TMEM + b * NMEM, (bf16_t*)(scr + S_XO) + r0 * 1024 + hd * 256); }
            break;
        case PT_FINAL: final_norm(a, rowss + RS_H0); break;
        default: break;
        }
        if (ph + 1 < a.ph_hi && ph + 1 < N_PHASES) {
            if (ph == a.ph_lo) {
                asm volatile("s_waitcnt vmcnt(0) lgkmcnt(0)" ::: "memory");
                __syncthreads();
                if (threadIdx.x < 64) { __builtin_amdgcn_fence(__ATOMIC_RELEASE, "agent"); asm volatile("s_waitcnt vmcnt(0) lgkmcnt(0)" ::: "memory"); }
                cg::this_grid().sync();
                __builtin_amdgcn_fence(__ATOMIC_ACQUIRE, "agent");
                asm volatile("s_waitcnt vmcnt(0) lgkmcnt(0)" ::: "memory");
            } else xcd_barrier(xb);
        }
    }
}

extern "C" void kernel_launch(void* const* d_in, const int* in_sizes, int n_in, void* d_out, int out_size, void* d_ws, size_t ws_size, hipStream_t stream) {
    static int grid = 0;
    if (grid == 0) {
        if (n_in != 29 || ws_size < WS_NEED) { fprintf(stderr, "kernel_launch: need 29 inputs and %zu bytes of workspace; got %d, %zu\n", (size_t)WS_NEED, n_in, ws_size); grid = -1; return; }
        int dev = 0, cus = 0, per_cu = 0;
        hipGetDevice(&dev); hipDeviceGetAttribute(&cus, hipDeviceAttributeMultiprocessorCount, dev);
        if (hipFuncSetAttribute((const void*)mk_fwd, hipFuncAttributeMaxDynamicSharedMemorySize, LDS_BYTES) != hipSuccess) { fprintf(stderr, "kernel_launch: hipFuncSetAttribute failed\n"); grid = -1; return; }
        if (hipOccupancyMaxActiveBlocksPerMultiprocessor(&per_cu, (const void*)mk_fwd, 512, LDS_BYTES) != hipSuccess || per_cu < 1) { fprintf(stderr, "kernel_launch: occupancy query says %d\n", per_cu); per_cu = 1; }
        (void)hipGetLastError();
        grid = cus;
    }
    if (grid < 0) return;
    Args a{};
    for (int i = 0; i < 29; ++i) a.in[i] = d_in[i];
    a.out = (float*)d_out; a.ws = (unsigned char*)d_ws; a.ph_lo = 0; a.ph_hi = 1000;
    (void)hipMemsetAsync((char*)d_ws + OFF_BAR, 0, 16384, stream);
    void* args[] = {&a};
    hipError_t e = hipLaunchCooperativeKernel((const void*)mk_fwd, dim3(grid), dim3(512), args, LDS_BYTES, stream);
    if (e != hipSuccess) fprintf(stderr, "cooperative launch failed: %s (grid %d)\n", hipGetErrorString(e), grid);
}
```

```cpp
#include <hip/hip_runtime.h>
#include <hip/hip_cooperative_groups.h>
#include <cstdio>
namespace cg = cooperative_groups;

#define LAS __attribute__((address_space(3)))
typedef unsigned short bf16_t;
typedef short bf16x8 __attribute__((ext_vector_type(8)));
typedef short bf16x4 __attribute__((ext_vector_type(4)));
typedef float f32x4 __attribute__((ext_vector_type(4)));
typedef unsigned u32x2 __attribute__((ext_vector_type(2)));
typedef unsigned u32x4 __attribute__((ext_vector_type(4)));

constexpr int T_TOK = 32768, DM = 1024, SEQ = 2048, NB = 16, DFF = 2816, NMEM = 256, TMEM = 4096;
constexpr float LOG2E = 1.4426950408889634f;
constexpr float EPS = 1e-6f;

constexpr size_t W_GU1 = 0, W_DN1 = 5767168, W_GU2 = 8650752, W_DN2 = 14417920, W_Q = 17301504, W_K = 18350080, W_V = 19398656, W_O = 20447232, W_MIX = 21495808;
constexpr size_t W_IN = W_MIX, W_UQ = W_IN + 3670016, W_KN = W_UQ + 393216, W_VV = W_KN + 131072, W_OY = W_VV + 131072, W_OO = W_OY + 1048576;
constexpr size_t W_FT = W_MIX, W_FOLD = W_FT + 1048576;
constexpr size_t WB_ELEMS = 27394048;
constexpr size_t OFF_WB = 0;
constexpr size_t OFF_FSEQ = OFF_WB + WB_ELEMS * 2;
constexpr size_t OFF_TCH = OFF_FSEQ + 8388608;
constexpr size_t OFF_HB = OFF_TCH + 262144;
constexpr size_t OFF_MEMB = OFF_HB + 67108864;
constexpr size_t OFF_KMEM = OFF_MEMB + 8388608;
constexpr size_t OFF_VTM = OFF_KMEM + 8388608;
constexpr size_t OFF_ROWSS = OFF_VTM + 8388608;
constexpr size_t RS_H0 = 0, RS_H1 = (size_t)T_TOK * 16, RS_CQ = (size_t)T_TOK * 32, RS_CKV = (size_t)T_TOK * 48, RS_G = (size_t)T_TOK * 64, RS_TOTAL = (size_t)T_TOK * 80;
constexpr size_t OFF_MEMSS = OFF_ROWSS + RS_TOTAL * 4;
constexpr size_t OFF_SCR = OFF_MEMSS + 4096 * 16 * 4;
constexpr size_t S_ACT = 0;
constexpr size_t S_XQ = 0, S_XO = 67108864;
constexpr size_t S_UT = 0, S_YCS = 67108864;
constexpr size_t S_Z = 0, S_XBC = 100663296, S_QB = S_XBC, S_KN = S_XBC + 50331648, S_CQ = 201326592, S_CKV = 234881024, S_DTRAW = 251658240,
                 S_KROPE = 255852544, S_XT = 257949696, S_BCC = 325058560, S_CUM = 358612992, S_END = 367001600;
constexpr size_t OFF_BAR = OFF_SCR + S_END;
constexpr size_t WS_NEED = OFF_BAR + 16384;
constexpr size_t CUM_ARR = (size_t)T_TOK * 16;

struct Args { const void* in[29]; float* out; unsigned char* ws; int ph_lo, ph_hi; };

__device__ __forceinline__ unsigned cvt_pk_bf16(float lo, float hi) { unsigned r; asm volatile("v_cvt_pk_bf16_f32 %0, %1, %2" : "=v"(r) : "v"(lo), "v"(hi)); return r; }
__device__ __forceinline__ float bf2f(unsigned short b) { return __uint_as_float(((unsigned)b) << 16); }
__device__ __forceinline__ float bflo(unsigned u) { return __uint_as_float(u << 16); }
__device__ __forceinline__ float bfhi(unsigned u) { return __uint_as_float(u & 0xffff0000u); }
__device__ __forceinline__ float fexp2(float x) { return __builtin_amdgcn_exp2f(x); }
__device__ __forceinline__ float frcp(float x) { return __builtin_amdgcn_rcpf(x); }
__device__ __forceinline__ float silu_f(float g) { return g * frcp(1.0f + fexp2(-g * LOG2E)); }
__device__ __forceinline__ float rstd_of(float ss, float inv_dim) { return rsqrtf(ss * inv_dim + EPS); }
__device__ __forceinline__ float shfl_xor_f(float v, int m) { return __shfl_xor(v, m, 64); }
__device__ __forceinline__ float ss_sum(const float* p, size_t row, int) {
    const f32x4* q = (const f32x4*)(p + row * 16); const f32x4 a = q[0], b = q[1], c = q[2], d = q[3];
    const f32x4 t = (a + b) + (c + d); return (t[0] + t[1]) + (t[2] + t[3]); }

__device__ __forceinline__ int opaque_tid() { int t = threadIdx.x; asm volatile("" : "+v"(t)); return t; }

__device__ __forceinline__ int xcd_item(int trip, int n_items) {
    const int x = blockIdx.x & 7, s = blockIdx.x >> 3, per = n_items >> 3, nslot = gridDim.x >> 3;
    const int local = trip * nslot + s; return local < per ? x * per + local : -1;
}

constexpr int BM = 256, BK = 64, HALF = 128, HTB = HALF * BK * 2, STAGE_BYTES = 8 * HTB, NXCD = 8, WGM = 8;
constexpr int LDS_XST = STAGE_BYTES, LDS_RSC = STAGE_BYTES + 256, LDS_BYTES = LDS_RSC + 512 * 36;
__device__ __forceinline__ int lds_byte(int r, int c) { const int st = (r >> 4) * 2 + (c >> 5), rr = r & 15, cc = c & 31, ob = rr * 64 + cc * 2; return st * 1024 + (ob ^ (((ob >> 9) & 1) << 5)); }
__device__ __forceinline__ void stage_rc(int b, int& R, int& C) { const int st = b / 1024, sb = b % 1024, swz = sb ^ (((sb >> 9) & 1) << 5); R = (st >> 1) * 16 + swz / 64; C = (st & 1) * 32 + (swz % 64) / 2; }

__device__ __forceinline__ int perm32(int rho) { const int n = rho >> 4, i = rho & 15; return 8 * (i >> 2) + 4 * n + (i & 3); }
struct Unit { int pm, pn, pz; };
struct Gemm { const bf16_t* A; const bf16_t* Bt; int lda, ldb, K, nM, nN, nZ, zd, rot; long sA1, sA2, sB1, sB2; };
__device__ __forceinline__ Gemm mk_gemm(const bf16_t* A, int lda, const bf16_t* Bt, int ldb, int K, int nM, int nN) {
    Gemm g; g.A = A; g.Bt = Bt; g.lda = lda; g.ldb = ldb; g.K = K; g.nM = nM; g.nN = nN; g.nZ = 1; g.zd = 1; g.rot = 0; g.sA1 = g.sA2 = g.sB1 = g.sB2 = 0; return g; }

__device__ __forceinline__ bool next_unit(const Gemm& g, int i, Unit& u) {
    const int nwg = g.nM * g.nN;
    const long L = (long)i * gridDim.x + (int)((blockIdx.x + gridDim.x - (unsigned)g.rot) % gridDim.x); if (L >= (long)nwg * g.nZ) return false;
    u.pz = (int)(L / nwg); int wgid = (int)(L % nwg);
    { const int q = nwg / NXCD, r = nwg % NXCD, xcd = wgid % NXCD, off = wgid / NXCD; wgid = (xcd < r ? xcd * (q + 1) : r * (q + 1) + (xcd - r) * q) + off; }
    const int nig = WGM * g.nN, gid = wgid / nig, fm = gid * WGM, gsz = (g.nM - fm) < WGM ? (g.nM - fm) : WGM;
    u.pm = fm + ((wgid % nig) % gsz); u.pn = (wgid % nig) / gsz; return true;
}
__device__ __forceinline__ const char* unit_A(const Gemm& g, const Unit& u) { return (const char*)(g.A + (size_t)(u.pz / g.zd) * g.sA1 + (size_t)(u.pz % g.zd) * g.sA2 + (size_t)u.pm * BM * g.lda); }
__device__ __forceinline__ const char* unit_B(const Gemm& g, const Unit& u) { return (const char*)(g.Bt + (size_t)(u.pz / g.zd) * g.sB1 + (size_t)(u.pz % g.zd) * g.sB2 + (size_t)u.pn * BM * g.ldb); }

template <class Epi>
__device__ __forceinline__ void gemm_phase(LAS unsigned char* lds, const Gemm g, const Epi& E) {
    int tid_ = threadIdx.x; asm volatile("" : "+v"(tid_));
    const int tid = tid_, wid = __builtin_amdgcn_readfirstlane(tid >> 6), lane = tid & 63, wr = wid >> 2, wc = wid & 3, fr = lane & 15, fq = lane >> 4;
    const int K = g.K, nt = K / BK;
    unsigned voffA[2], voffB[2];
#pragma unroll
    for (int i = 0; i < 2; ++i) { int R, C; stage_rc(tid * 16 + i * 8192, R, C);
        const int Rb = Epi::PERM ? ((R & ~31) + perm32(R & 31)) : R;
        voffA[i] = (unsigned)(R * g.lda + C) * 2u; voffB[i] = (unsigned)(Rb * g.ldb + C) * 2u; }
    const size_t kstep = (size_t)(BK * 2);
    const size_t hstepA = (size_t)HALF * g.lda * 2, hstepB = (size_t)HALF * g.ldb * 2;
    const unsigned ldsw = (unsigned)wid * 1024u;
    const int aoff = lds_byte(wr * 64 + fr, fq * 8), boff = lds_byte(wc * 32 + fr, fq * 8);
#define PG8_SA(b, h) (((b) * 2 + (h)) * HTB)
#define PG8_SB(b, h) ((4 + (b) * 2 + (h)) * HTB)
#define PG8_STAGE(bufoff, gbase, voff) do { _Pragma("unroll") for (int _i = 0; _i < 2; ++_i) \
        __builtin_amdgcn_global_load_lds((const unsigned*)((const char*)(gbase) + (voff)[_i]), (LAS unsigned*)(lds + (bufoff) + ldsw + _i * 8192), 16, 0, 0); } while (0)
#define PG8_LDA(dst, b, h) do { _Pragma("unroll") for (int m = 0; m < 4; ++m) _Pragma("unroll") for (int k = 0; k < 2; ++k) dst[m][k] = *(const LAS bf16x8*)(lds + PG8_SA(b, h) + aoff + m * 2048 + k * 1024); } while (0)
#define PG8_LDB(dst, b, h) do { _Pragma("unroll") for (int n = 0; n < 2; ++n) _Pragma("unroll") for (int k = 0; k < 2; ++k) dst[n][k] = *(const LAS bf16x8*)(lds + PG8_SB(b, h) + boff + n * 2048 + k * 1024); } while (0)
#define PG8_MMA(ai, bj, At, Bt) do { __builtin_amdgcn_s_setprio(1); _Pragma("unroll") for (int m = 0; m < 4; ++m) _Pragma("unroll") for (int n = 0; n < 2; ++n) _Pragma("unroll") for (int k = 0; k < 2; ++k) \
        acc[ai][bj][m][n] = __builtin_amdgcn_mfma_f32_16x16x32_bf16(Bt[n][k], At[m][k], acc[ai][bj][m][n], 0, 0, 0); __builtin_amdgcn_s_setprio(0); } while (0)
#define PG8_WAIT_V(n) asm volatile("s_waitcnt vmcnt(" #n ")" ::: "memory")
#define PG8_WAIT_L(n) asm volatile("s_waitcnt lgkmcnt(" #n ")" ::: "memory")
#define PG8_BAR __builtin_amdgcn_s_barrier()
#define PG8_SCHED __builtin_amdgcn_sched_barrier(0)
    Unit cur, nxt; int ui = 0;
    if (!next_unit(g, 0, cur)) return;
    f32x4 acc[2][2][4][2];
#pragma unroll
    for (int a = 0; a < 2; ++a)
#pragma unroll
        for (int b = 0; b < 2; ++b)
#pragma unroll
            for (int m = 0; m < 4; ++m)
#pragma unroll
                for (int n = 0; n < 2; ++n) acc[a][b][m][n] = (f32x4){0.f, 0.f, 0.f, 0.f};
    bf16x8 At[4][2], B0[2][2], B1[2][2];
    const char* cA = unit_A(g, cur); const char* cB = unit_B(g, cur);
    PG8_STAGE(PG8_SB(0, 0), cB, voffB); PG8_STAGE(PG8_SA(0, 0), cA, voffA); PG8_STAGE(PG8_SB(0, 1), cB + hstepB, voffB); PG8_STAGE(PG8_SA(0, 1), cA + hstepA, voffA);
    if (wr == 1) PG8_BAR;
    PG8_WAIT_V(4); PG8_BAR;
    PG8_STAGE(PG8_SB(1, 0), cB + kstep, voffB); PG8_STAGE(PG8_SA(1, 0), cA + kstep, voffA); PG8_STAGE(PG8_SB(1, 1), cB + hstepB + kstep, voffB);
    PG8_WAIT_V(6); PG8_BAR;
    for (;;) {
        const bool has_next = next_unit(g, ui + 1, nxt);
        const char* nA = has_next ? unit_A(g, nxt) : cA; const char* nB = has_next ? unit_B(g, nxt) : cB;
        for (int t = 0; t < nt; t += 2) {
            const bool last = (t == nt - 2);
            const char* a1 = cA + (size_t)(t + 1) * kstep;
            const char* a2 = last ? nA : cA + (size_t)(t + 2) * kstep; const char* b2 = last ? nB : cB + (size_t)(t + 2) * kstep;
            const char* a3 = a2 + kstep; const char* b3 = b2 + kstep;
            PG8_LDB(B0, 0, 0); PG8_SCHED; PG8_LDA(At, 0, 0); PG8_STAGE(PG8_SA(1, 1), a1 + hstepA, voffA);
            PG8_WAIT_L(8); PG8_BAR; PG8_WAIT_L(0); PG8_MMA(0, 0, At, B0); PG8_BAR; PG8_SCHED;
            PG8_LDB(B1, 0, 1); PG8_STAGE(PG8_SB(0, 0), b2, voffB);
            PG8_BAR; PG8_WAIT_L(0); PG8_MMA(0, 1, At, B1); PG8_BAR;
            PG8_LDA(At, 0, 1); PG8_STAGE(PG8_SA(0, 0), a2, voffA);
            PG8_BAR; PG8_WAIT_L(0); PG8_MMA(1, 0, At, B0); PG8_BAR; PG8_SCHED;
            PG8_STAGE(PG8_SB(0, 1), b2 + hstepB, voffB);
            PG8_WAIT_V(6); PG8_BAR; PG8_MMA(1, 1, At, B1); PG8_BAR;
            PG8_LDB(B0, 1, 0); PG8_SCHED; PG8_LDA(At, 1, 0); PG8_STAGE(PG8_SA(0, 1), a2 + hstepA, voffA);
            PG8_WAIT_L(8); PG8_BAR; PG8_WAIT_L(0); PG8_MMA(0, 0, At, B0); PG8_BAR; PG8_SCHED;
            PG8_LDB(B1, 1, 1); PG8_STAGE(PG8_SB(1, 0), b3, voffB);
            PG8_BAR; PG8_WAIT_L(0); PG8_MMA(0, 1, At, B1); PG8_BAR;
            PG8_LDA(At, 1, 1); PG8_STAGE(PG8_SA(1, 0), a3, voffA);
            PG8_BAR; PG8_WAIT_L(0); PG8_MMA(1, 0, At, B0); PG8_BAR; PG8_SCHED;
            PG8_STAGE(PG8_SB(1, 1), b3 + hstepB, voffB);
            PG8_WAIT_V(6); PG8_BAR; PG8_MMA(1, 1, At, B1); PG8_BAR;
        }
        E(acc, cur, wr, wc, fr, fq);
        if (!has_next) break;
#pragma unroll
        for (int a = 0; a < 2; ++a)
#pragma unroll
            for (int b = 0; b < 2; ++b)
#pragma unroll
                for (int m = 0; m < 4; ++m)
#pragma unroll
                    for (int n = 0; n < 2; ++n) acc[a][b][m][n] = (f32x4){0.f, 0.f, 0.f, 0.f};
        cur = nxt; cA = nA; cB = nB; ++ui;
    }
    PG8_WAIT_V(0);
    if (wr == 0) PG8_BAR;
    PG8_BAR;
#undef PG8_SA
#undef PG8_SB
#undef PG8_STAGE
#undef PG8_LDA
#undef PG8_LDB
#undef PG8_MMA
#undef PG8_WAIT_V
#undef PG8_WAIT_L
#undef PG8_BAR
#undef PG8_SCHED
}

typedef f32x4 AccT[2][2][4][2];
#define EPI_ROWS_BEGIN _Pragma("unroll") for (int ai = 0; ai < 2; ++ai) _Pragma("unroll") for (int m = 0; m < 4; ++m) { const int row = u.pm * BM + ai * HALF + wr * 64 + m * 16 + fr;
#define EPI_ROWS_END }
#define EPI_RS_BATCH(RSV, PTR, W, INVDIM) float RSV[8]; { LAS float* _c = rsc; \
    if ((PTR) && __float_as_int(_c[0]) == u.pm) { _Pragma("unroll") for (int _k = 0; _k < 8; ++_k) RSV[_k] = _c[1 + _k]; }       \
    else { float _s[8]; _Pragma("unroll") for (int _k = 0; _k < 8; ++_k) { const int _row = u.pm * BM + (_k >> 2) * HALF + wr * 64 + (_k & 3) * 16 + fr; _s[_k] = (PTR) ? ss_sum((PTR), (size_t)_row, (W)) : 0.f; } \
        _Pragma("unroll") for (int _k = 0; _k < 8; ++_k) RSV[_k] = (PTR) ? rstd_of(_s[_k], (INVDIM)) : 1.0f; \
        if (PTR) { _c[0] = __int_as_float(u.pm); _Pragma("unroll") for (int _k = 0; _k < 8; ++_k) _c[1 + _k] = RSV[_k]; } } }

struct EpiSwiglu {
    static constexpr bool PERM = true;
    bf16_t* act; const float* rss; int rss_w; LAS float* rsc;
    __device__ __forceinline__ void operator()(AccT& acc, const Unit& u, int wr, int wc, int fr, int fq) const {
        EPI_RS_BATCH(rsv, rss, rss_w, 1.0f / DM)
        EPI_ROWS_BEGIN
            const float rs = rsv[ai * 4 + m];
            bf16_t* rp = act + (size_t)row * DFF + u.pn * 128 + wc * 32 + 8 * fq;
            unsigned o[4];
#pragma unroll
            for (int n = 0; n < 2; ++n) { f32x4 gv = acc[ai][0][m][n] * rs, uv = acc[ai][1][m][n] * rs;
                o[2 * n] = cvt_pk_bf16(silu_f(gv[0]) * uv[0], silu_f(gv[1]) * uv[1]); o[2 * n + 1] = cvt_pk_bf16(silu_f(gv[2]) * uv[2], silu_f(gv[3]) * uv[3]); }
            __builtin_nontemporal_store((u32x4){o[0], o[1], o[2], o[3]}, (u32x4*)rp);
        EPI_ROWS_END
    }
};
struct EpiResid {
    static constexpr bool PERM = true;
    const float* hin; float* hout; bf16_t* hb; float* ss_out; const float* rss; int rss_w; float rss_inv_dim; float alpha; LAS float* rsc;
    __device__ __forceinline__ void operator()(AccT& acc, const Unit& u, int wr, int wc, int fr, int fq) const {
        EPI_RS_BATCH(rsv, rss, rss_w, rss_inv_dim)
#pragma unroll
        for (int ah = 0; ah < 4; ++ah) { const int ai = ah >> 1, m0 = (ah & 1) * 2;
            f32x4 hv[4][2][2];
#pragma unroll
            for (int m = m0; m < m0 + 2; ++m) { const int row = u.pm * BM + ai * HALF + wr * 64 + m * 16 + fr; const size_t base = (size_t)row * DM + u.pn * BM + wc * 32 + 8 * fq;
#pragma unroll
                for (int bj = 0; bj < 2; ++bj)
#pragma unroll
                    for (int n = 0; n < 2; ++n) hv[m][bj][n] = *(const f32x4*)(hin + base + bj * HALF + n * 4); }
#pragma unroll
            for (int m = m0; m < m0 + 2; ++m) { const int row = u.pm * BM + ai * HALF + wr * 64 + m * 16 + fr; const size_t base = (size_t)row * DM + u.pn * BM + wc * 32 + 8 * fq;
                const float sc = alpha * rsv[ai * 4 + m]; float ss = 0.f;
#pragma unroll
                for (int bj = 0; bj < 2; ++bj) { const size_t o = base + bj * HALF;
                    const f32x4 ha = hv[m][bj][0] + acc[ai][bj][m][0] * sc, hc = hv[m][bj][1] + acc[ai][bj][m][1] * sc;
                    *(f32x4*)(hout + o) = ha; *(f32x4*)(hout + o + 4) = hc;
                    if (hb) *(u32x4*)(hb + o) = (u32x4){cvt_pk_bf16(ha[0], ha[1]), cvt_pk_bf16(ha[2], ha[3]), cvt_pk_bf16(hc[0], hc[1]), cvt_pk_bf16(hc[2], hc[3])};
                    ss += ha[0] * ha[0] + ha[1] * ha[1] + ha[2] * ha[2] + ha[3] * ha[3] + hc[0] * hc[0] + hc[1] * hc[1] + hc[2] * hc[2] + hc[3] * hc[3]; }
                if (ss_out) { ss += shfl_xor_f(ss, 16); ss += shfl_xor_f(ss, 32); if (fq == 0) ss_out[(size_t)row * 16 + u.pn * 4 + wc] = ss; } }
        }
    }
};
template <int MODE, bool ROPE> struct EpiStore {
    static constexpr bool PERM = !ROPE;
    bf16_t* out; long ldc; const float* rss; int rss_w; float rs_inv_dim; const float* css; int css_w; float cs_inv_dim; long zoff; const int* pos; LAS float* rsc;
    __device__ __forceinline__ void operator()(AccT& acc, const Unit& u, int wr, int wc, int fr, int fq) const {
        bf16_t* ob = out + (size_t)u.pz * zoff; int rbase = u.pm * BM, cbase = u.pn * BM;
        if (MODE == 1) { const int b = u.pn >> 2; ob = out + ((size_t)b * SEQ) * 2048; cbase = (u.pn & 3) * BM; }
        if (css) {
#pragma unroll
            for (int bj = 0; bj < 2; ++bj)
#pragma unroll
                for (int n = 0; n < 2; ++n) { const size_t c0 = (size_t)(u.pn * BM + bj * HALF + wc * 32 + (PERM ? 8 * fq + 4 * n : n * 16 + 4 * fq));
                    const f32x4 cv = (f32x4){rstd_of(ss_sum(css, c0, css_w), cs_inv_dim), rstd_of(ss_sum(css, c0 + 1, css_w), cs_inv_dim), rstd_of(ss_sum(css, c0 + 2, css_w), cs_inv_dim), rstd_of(ss_sum(css, c0 + 3, css_w), cs_inv_dim)};
#pragma unroll
                    for (int ai = 0; ai < 2; ++ai)
#pragma unroll
                        for (int m = 0; m < 4; ++m) acc[ai][bj][m][n] *= cv; }
        }
        EPI_RS_BATCH(rsv, rss, rss_w, rs_inv_dim)
        EPI_ROWS_BEGIN
            const float rs = rsv[ai * 4 + m];
            int lrow = rbase + ai * HALF + wr * 64 + m * 16 + fr; int mrow = -1; float msgn = 1.0f; long mcoff = 0;
            if (MODE == 1) {
                const int r = lrow; if (r <= 1024) { mrow = (r >= 1 && r < 1024) ? 2048 - r : -1; } else { lrow = r - 1024; mrow = 2048 - lrow; mcoff = 1024; msgn = -1.0f; }
                if (r == 1024) { bf16_t* z0 = ob + 1024 + cbase + wc * 32 + 8 * fq; bf16_t* z1 = z0 + (size_t)1024 * 2048; const u32x4 zz = (u32x4){0u, 0u, 0u, 0u};
#pragma unroll
                    for (int bj = 0; bj < 2; ++bj) { *(u32x4*)(z0 + bj * HALF) = zz; *(u32x4*)(z1 + bj * HALF) = zz; } } }
            bf16_t* rp = ob + (size_t)lrow * ldc + mcoff + cbase + wc * 32 + (PERM ? 8 : 4) * fq;
            float fpos = 0.f; if (ROPE) fpos = (float)pos[row];
#pragma unroll
            for (int bj = 0; bj < 2; ++bj) {
                f32x4 v0 = acc[ai][bj][m][0] * rs, v1 = acc[ai][bj][m][1] * rs;
                if (ROPE) { const int G = (u.pn * BM + bj * HALF + wc * 32) >> 5;
                    if (G % 3 == 2) {
#pragma unroll
                        for (int e = 0; e < 4; ++e) { const int fi = 4 * fq + e; const float inv = fexp2(-(float)fi * (13.287712379549449f / 16.0f));
                            float t = fpos * inv * 0.15915494309189535f; t -= floorf(t);
                            const float sn = __builtin_amdgcn_sinf(t), cn = __builtin_amdgcn_cosf(t);
                            const float x1 = v0[e], x2 = v1[e]; v0[e] = x1 * cn - x2 * sn; v1[e] = x1 * sn + x2 * cn; } } }
                u32x2 p0, p1; p0.x = cvt_pk_bf16(v0[0], v0[1]); p0.y = cvt_pk_bf16(v0[2], v0[3]); p1.x = cvt_pk_bf16(v1[0], v1[1]); p1.y = cvt_pk_bf16(v1[2], v1[3]);
                if (PERM) *(u32x4*)(rp + bj * HALF) = (u32x4){p0.x, p0.y, p1.x, p1.y}; else { *(u32x2*)(rp + bj * HALF) = p0; *(u32x2*)(rp + bj * HALF + 16) = p1; }
                if (MODE == 1 && mrow >= 0) { bf16_t* mp = ob + (size_t)mrow * ldc + mcoff + cbase + wc * 32 + 8 * fq;
                    if (msgn < 0.f) { p0.x ^= 0x80008000u; p0.y ^= 0x80008000u; p1.x ^= 0x80008000u; p1.y ^= 0x80008000u; }
                    *(u32x4*)(mp + bj * HALF) = (u32x4){p0.x, p0.y, p1.x, p1.y}; } }
        EPI_ROWS_END
    }
};
struct EpiWin {
    static constexpr bool PERM = false;
    unsigned char* scr; const float* rss; int rss_w; float* ss_cq; float* ss_ckv; const int* pos; LAS float* rsc;
    __device__ __forceinline__ void operator()(AccT& acc, const Unit& u, int wr, int wc, int fr, int fq) const {
        const int pn = u.pn;
        EPI_RS_BATCH(rsv, rss, rss_w, 1.0f / DM)
        EPI_ROWS_BEGIN
            const float rs = rsv[ai * 4 + m];
            if (pn < 13) {
                bf16_t* rp; float* ssp = nullptr; size_t ssi = 0;
                if (pn < 4) rp = (bf16_t*)(scr + S_Z) + (size_t)row * 1536 + pn * BM;
                else if (pn < 10) rp = (bf16_t*)(scr + S_XBC) + (size_t)row * 1536 + (pn - 4) * BM;
                else if (pn < 12) { rp = (bf16_t*)(scr + S_CQ) + (size_t)row * 512 + (pn - 10) * BM; ssp = ss_cq; ssi = (size_t)row * 16 + (pn - 10) * 4 + wc; }
                else { rp = (bf16_t*)(scr + S_CKV) + (size_t)row * 256; ssp = ss_ckv; ssi = (size_t)row * 16 + wc; }
                rp += wc * 32 + 4 * fq; float ss = 0.f;
#pragma unroll
                for (int bj = 0; bj < 2; ++bj)
#pragma unroll
                    for (int n = 0; n < 2; ++n) { f32x4 v = acc[ai][bj][m][n] * rs; u32x2 p; p.x = cvt_pk_bf16(v[0], v[1]); p.y = cvt_pk_bf16(v[2], v[3]);
                        *(u32x2*)(rp + bj * HALF + n * 16) = p; ss += v[0] * v[0] + v[1] * v[1] + v[2] * v[2] + v[3] * v[3]; }
                if (ssp) { ss += shfl_xor_f(ss, 16); ss += shfl_xor_f(ss, 32);
                    if (fq == 0) { ssp[ssi] = ss; if (pn == 12) { ssp[ssi + 4] = 0.f; ssp[ssi + 8] = 0.f; ssp[ssi + 12] = 0.f; } else ssp[ssi + 8] = 0.f; } }
            } else {
                if (wc == 0) {
                    float* dp = (float*)(scr + S_DTRAW) + (size_t)row * 32 + 4 * fq;
                    *(f32x4*)dp = acc[ai][0][m][0] * rs; *(f32x4*)(dp + 16) = acc[ai][0][m][1] * rs;
                } else if (wc == 1) {
                    f32x4 v0 = acc[ai][0][m][0] * rs, v1 = acc[ai][0][m][1] * rs; const float fpos = (float)pos[row];
#pragma unroll
                    for (int e = 0; e < 4; ++e) { const int fi = 4 * fq + e; const float inv = fexp2(-(float)fi * (13.287712379549449f / 16.0f));
                        float t = fpos * inv * 0.15915494309189535f; t -= floorf(t);
                        const float sn = __builtin_amdgcn_sinf(t), cn = __builtin_amdgcn_cosf(t);
                        const float x1 = v0[e], x2 = v1[e]; v0[e] = x1 * cn - x2 * sn; v1[e] = x1 * sn + x2 * cn; }
                    bf16_t* kp = (bf16_t*)(scr + S_KROPE) + (size_t)row * 32 + 4 * fq;
                    u32x2 p0, p1; p0.x = cvt_pk_bf16(v0[0], v0[1]); p0.y = cvt_pk_bf16(v0[2], v0[3]); p1.x = cvt_pk_bf16(v1[0], v1[1]); p1.y = cvt_pk_bf16(v1[2], v1[3]);
                    *(u32x2*)kp = p0; *(u32x2*)(kp + 16) = p1;
                }
            }
        EPI_ROWS_END
    }
};

__device__ __forceinline__ int colmap(int map, int j) {
    switch (map) {
        case 1: { const int t = j >> 8, w = j & 255; return (w >> 7) * DFF + t * 128 + (w & 127); }
        case 2: return j < 2560 ? j : (j < 3328 ? j + 32 : (j < 3360 ? j - 768 : (j < 3392 ? j : -1)));
        case 3: return (j >> 6) * 128 + (j & 63);
        case 4: return (j >> 6) * 128 + 64 + (j & 63);
        default: return j;
    }
}
__device__ __attribute__((noinline)) void convT(LAS float* tile, const float* src, int ldsrc, int K, bf16_t* dst, int ldd, int ndst, int map, const float* kscale, float scalar) {
    const int tid = opaque_tid(), nkt = K >> 6, ntiles = (ndst >> 8) * nkt;
    for (int t = blockIdx.x; t < ntiles; t += gridDim.x) {
        const int n0 = (t / nkt) << 8, k0 = (t % nkt) << 6;
        { const int k = tid >> 3, nv = tid & 7; f32x4 va[4], vb[4];
#pragma unroll
          for (int j = 0; j < 4; ++j) { const int sc = colmap(map, n0 + 64 * j + 8 * nv); va[j] = (f32x4){0.f, 0.f, 0.f, 0.f}; vb[j] = va[j];
              if (sc >= 0) { const float* p = src + (size_t)(k0 + k) * ldsrc + sc; va[j] = *(const f32x4*)p; vb[j] = *(const f32x4*)(p + 4); } }
          const float s = (kscale ? kscale[k0 + k] : 1.0f) * scalar;
#pragma unroll
          for (int j = 0; j < 4; ++j) { LAS float* tp = tile + k * 257 + 64 * j + 8 * nv;
              tp[0] = va[j][0] * s; tp[1] = va[j][1] * s; tp[2] = va[j][2] * s; tp[3] = va[j][3] * s; tp[4] = vb[j][0] * s; tp[5] = vb[j][1] * s; tp[6] = vb[j][2] * s; tp[7] = vb[j][3] * s; } }
        __syncthreads();
        { const int kv = tid & 7;
#pragma unroll
          for (int j = 0; j < 4; ++j) { const int n = (tid >> 3) + 64 * j; const LAS float* tp = tile + (8 * kv) * 257 + n;
              u32x4 o; o.x = cvt_pk_bf16(tp[0], tp[257]); o.y = cvt_pk_bf16(tp[514], tp[771]); o.z = cvt_pk_bf16(tp[1028], tp[1285]); o.w = cvt_pk_bf16(tp[1542], tp[1799]);
              *(u32x4*)(dst + (size_t)(n0 + n) * ldd + k0 + 8 * kv) = o; } }
        __syncthreads();
    }
}
__device__ void convert_layer(const Args& a, int l, LAS float* tile) {
    bf16_t* wb = (bf16_t*)(a.ws + OFF_WB);
    const float* const* in = (const float* const*)a.in;
    convT(tile, in[6] + (size_t)l * DM * 2 * DFF, 2 * DFF, DM, wb + W_GU1, DM, 2 * DFF, 1, in[5] + l * DM, 1.0f);
    convT(tile, in[7] + (size_t)l * DFF * DM, DM, DFF, wb + W_DN1, DFF, DM, 0, nullptr, 1.0f);
    convT(tile, in[14] + (size_t)l * DM * 2 * DFF, 2 * DFF, DM, wb + W_GU2, DM, 2 * DFF, 1, in[13] + l * DM, 1.0f);
    convT(tile, in[15] + (size_t)l * DFF * DM, DM, DFF, wb + W_DN2, DFF, DM, 0, nullptr, 1.0f);
    convT(tile, in[10] + (size_t)l * DM * DM, DM, DM, wb + W_Q, DM, DM, 0, in[9] + l * DM, 0.0625f * LOG2E);
    convT(tile, in[11] + (size_t)l * DM * 2 * DM, 2 * DM, DM, wb + W_K, DM, DM, 0, in[3], 1.0f);
    convT(tile, in[11] + (size_t)l * DM * 2 * DM + DM, 2 * DM, DM, wb + W_V, DM, DM, 0, in[3], 1.0f);
    convT(tile, in[12] + (size_t)l * DM * DM, DM, DM, wb + W_O, DM, DM, 0, nullptr, 1.0f);
    if ((l & 1) == 0) { const int e = l >> 1;
        convT(tile, in[16] + (size_t)e * DM * 3392, 3392, DM, wb + W_IN, DM, 3584, 2, in[8] + l * DM, 1.0f);
        convT(tile, in[24] + (size_t)e * 512 * 768, 768, 512, wb + W_UQ, 512, 768, 0, in[23] + e * 512, 0.10206207261596577f * LOG2E);
        convT(tile, in[26] + (size_t)e * 256 * 1024, 1024, 256, wb + W_KN, 256, 512, 3, in[25] + e * 256, 1.0f);
        convT(tile, in[26] + (size_t)e * 256 * 1024, 1024, 256, wb + W_VV, 256, 512, 4, in[25] + e * 256, 1.0f);
        convT(tile, in[27] + (size_t)e * 1536 * 1024, 1024, 1024, wb + W_OY, 1536, 1024, 0, in[22] + e * 1024, 1.0f);
        convT(tile, in[27] + (size_t)e * 1536 * 1024 + (size_t)1024 * 1024, 1024, 512, wb + W_OY + 1024, 1536, 1024, 0, nullptr, 1.0f);
    } else { const int o = l >> 1;
        convT(tile, in[28] + (size_t)o * DM * DM, DM, DM, wb + W_FT, DM, DM, 0, nullptr, 1.0f);
    }
}

__device__ void rows_to_bf16(const float* src, bf16_t* dst, float* ss, int nrows, int w) {
    const int tid = opaque_tid(); const int lane = tid & 63, wv = tid >> 6;
    const int per = nrows >> 3, rbeg = (int)(blockIdx.x & 7) * per;
    for (int rl = ((int)(blockIdx.x >> 3) * 8 + wv) * 4; rl < per; rl += (int)(gridDim.x >> 3) * 32) { const int r0 = rbeg + rl;
        f32x4 v[4][4];
#pragma unroll
        for (int q = 0; q < 4; ++q)
#pragma unroll
            for (int k = 0; k < 4; ++k) v[q][k] = *(const f32x4*)(src + (size_t)(r0 + q) * DM + lane * 4 + k * 256);
#pragma unroll
        for (int q = 0; q < 4; ++q) { bf16_t* qd = dst + (size_t)(r0 + q) * DM + lane * 4; float s = 0.f;
#pragma unroll
            for (int k = 0; k < 4; ++k) { const f32x4 x = v[q][k]; s += x[0] * x[0] + x[1] * x[1] + x[2] * x[2] + x[3] * x[3];
                u32x2 o; o.x = cvt_pk_bf16(x[0], x[1]); o.y = cvt_pk_bf16(x[2], x[3]); *(u32x2*)(qd + k * 256) = o; }
#pragma unroll
            for (int o = 32; o > 0; o >>= 1) s += shfl_xor_f(s, o);
            if (lane < w) ss[(size_t)(r0 + q) * w + lane] = lane == 0 ? s : 0.f; }
    }
}
__device__ void gen_tables(const Args& a) {
    bf16_t* F = (bf16_t*)(a.ws + OFF_FSEQ); bf16_t* Tc = (bf16_t*)(a.ws + OFF_TCH);
    const size_t gt = (size_t)blockIdx.x * blockDim.x + opaque_tid(), gs = (size_t)gridDim.x * blockDim.x;
    const float scale = 0.001381067932004976f;
    for (size_t i = gt; i < (size_t)2048 * 256; i += gs) {
        const int row = (int)(i >> 8), c0 = (int)(i & 255) * 8, cs = row > 1024 ? 1 : 0, sp = cs ? row - 1024 : row; unsigned w[4];
#pragma unroll
        for (int e = 0; e < 8; e += 2) { float v[2];
#pragma unroll
            for (int x = 0; x < 2; ++x) { const int k = (sp * (c0 + e + x)) & 2047; const float t = (float)k * (1.0f / 2048.0f);
                v[x] = (cs ? __builtin_amdgcn_sinf(t) : __builtin_amdgcn_cosf(t)) * scale; }
            w[e >> 1] = cvt_pk_bf16(v[0], v[1]); }
        *(u32x4*)(F + (size_t)row * 2048 + c0) = (u32x4){w[0], w[1], w[2], w[3]};
    }
    for (size_t i = gt; i < (size_t)2 * 256 * 32; i += gs) {
        const int cs = (int)(i >> 13), c = (int)((i >> 5) & 255), c0 = (int)(i & 31) * 8; unsigned w[4];
#pragma unroll
        for (int e = 0; e < 8; e += 2) { float v[2];
#pragma unroll
            for (int x = 0; x < 2; ++x) { const int k = (c * (c0 + e + x)) & 255; const float t = (float)k * (1.0f / 256.0f);
                v[x] = cs ? -__builtin_amdgcn_sinf(t) : __builtin_amdgcn_cosf(t); }
            w[e >> 1] = cvt_pk_bf16(v[0], v[1]); }
        *(u32x4*)(Tc + (size_t)cs * 65536 + (size_t)c * 256 + c0) = (u32x4){w[0], w[1], w[2], w[3]};
    }
}

__device__ void conv_phase(const Args& a, int e, LAS unsigned char* lds) {
    unsigned char* scr = a.ws + OFF_SCR;
    const bf16_t* xbc = (const bf16_t*)(scr + S_XBC);
    const float* cw = (const float*)a.in[17] + (size_t)e * 5 * 1536; const float* cb = (const float*)a.in[18] + (size_t)e * 1536;
    const int tid = opaque_tid();
    LAS bf16_t* tl = (LAS bf16_t*)lds;
    bf16_t* xT = (bf16_t*)(scr + S_XT);
    for (int trip = 0; ; ++trip) { const int it = xcd_item(trip, NB * 32 * 8); if (it < 0) break;
        const int b = it >> 8, st = (it >> 3) & 31, ct = it & 7, s0 = st * 64, c0 = ct * 128;
        { const int s = tid >> 3, cv = tid & 7; u32x4 xv[2][5];
#pragma unroll
          for (int j = 0; j < 2; ++j)
#pragma unroll
              for (int k = 0; k < 5; ++k) { const int sp = s0 + s + k - 2; xv[j][k] = (u32x4){0u, 0u, 0u, 0u};
                  if (sp >= 0 && sp < SEQ) xv[j][k] = *(const u32x4*)(xbc + ((size_t)b * SEQ + sp) * 1536 + c0 + 64 * j + 8 * cv); }
#pragma unroll
          for (int j = 0; j < 2; ++j) { const int ch = c0 + 64 * j + 8 * cv; float accv[8];
#pragma unroll
              for (int x = 0; x < 8; ++x) accv[x] = cb[ch + x];
#pragma unroll
              for (int k = 0; k < 5; ++k) { const u32x4 v = xv[j][k]; const float* wp = cw + k * 1536 + ch;
                  const f32x4 w0 = *(const f32x4*)wp, w1 = *(const f32x4*)(wp + 4);
                  accv[0] += bflo(v.x) * w0[0]; accv[1] += bfhi(v.x) * w0[1]; accv[2] += bflo(v.y) * w0[2]; accv[3] += bfhi(v.y) * w0[3];
                  accv[4] += bflo(v.z) * w1[0]; accv[5] += bfhi(v.z) * w1[1]; accv[6] += bflo(v.w) * w1[2]; accv[7] += bfhi(v.w) * w1[3]; }
#pragma unroll
              for (int x = 0; x < 8; x += 2) { const unsigned p = cvt_pk_bf16(silu_f(accv[x]), silu_f(accv[x + 1]));
                  tl[(64 * j + 8 * cv + x) * 72 + s] = (bf16_t)(p & 0xffff); tl[(64 * j + 8 * cv + x + 1) * 72 + s] = (bf16_t)(p >> 16); } } }
        __syncthreads();
        { const int sv = tid & 7;
#pragma unroll
          for (int j = 0; j < 2; ++j) { const int ch = (tid >> 3) + 64 * j; const u32x4 v = *(const LAS u32x4*)(tl + ch * 72 + 8 * sv);
              *(u32x4*)(xT + ((size_t)b * 1024 + c0 + ch) * SEQ + s0 + 8 * sv) = v; } }
        __syncthreads();
    }
    bf16_t* bcc = (bf16_t*)(scr + S_BCC);
    for (int trip = 0; ; ++trip) { const int itb = xcd_item(trip, T_TOK / 8); if (itb < 0) break; const size_t i = (size_t)itb * 512 + tid;
        const int row = (int)(i >> 6), ch = 1024 + (int)(i & 63) * 8, s = row & (SEQ - 1); float accv[8];
#pragma unroll
        for (int x = 0; x < 8; ++x) accv[x] = cb[ch + x];
#pragma unroll
        for (int k = 0; k < 5; ++k) { const int sp = s + k - 2;
            if (sp >= 0 && sp < SEQ) { const u32x4 v = *(const u32x4*)(xbc + ((size_t)row + k - 2) * 1536 + ch); const float* wp = cw + k * 1536 + ch;
                const f32x4 w0 = *(const f32x4*)wp, w1 = *(const f32x4*)(wp + 4);
                accv[0] += bflo(v.x) * w0[0]; accv[1] += bfhi(v.x) * w0[1]; accv[2] += bflo(v.y) * w0[2]; accv[3] += bfhi(v.y) * w0[3];
                accv[4] += bflo(v.z) * w1[0]; accv[5] += bfhi(v.z) * w1[1]; accv[6] += bflo(v.w) * w1[2]; accv[7] += bfhi(v.w) * w1[3]; } }
        u32x4 o; o.x = cvt_pk_bf16(silu_f(accv[0]), silu_f(accv[1])); o.y = cvt_pk_bf16(silu_f(accv[2]), silu_f(accv[3]));
        o.z = cvt_pk_bf16(silu_f(accv[4]), silu_f(accv[5])); o.w = cvt_pk_bf16(silu_f(accv[6]), silu_f(accv[7]));
        *(u32x4*)(bcc + (size_t)row * 512 + (ch - 1024)) = o;
    }
    const float* dtraw = (const float*)(scr + S_DTRAW); float* cum = (float*)(scr + S_CUM);
    const float* dtb = (const float*)a.in[19] + e * 32; const float* alog = (const float*)a.in[20] + e * 32;
    const int lane = tid & 63, wv = tid >> 6;
    for (int it = wv * gridDim.x + blockIdx.x; it < NB * 32; it += gridDim.x * 8) {
        const int b = it >> 5, dr = it & 31, dir = dr >> 4, r = dr & 15;
        const float bias = dtb[dr], A = -expf(alog[dr]);
        const float* src = dtraw + ((size_t)b * SEQ + lane * 32) * 32 + dr;
        float xr[32];
#pragma unroll
        for (int k = 0; k < 32; ++k) xr[k] = src[(size_t)k * 32];
        float tot = 0.f;
#pragma unroll
        for (int k = 0; k < 32; ++k) { const float x = xr[k] + bias; const float dt = fmaxf(x, 0.f) + log1pf(expf(-fabsf(x))); xr[k] = dt; tot += dt * A; }
        float incl = tot;
#pragma unroll
        for (int o = 1; o < 64; o <<= 1) { const float v = __shfl_up(incl, o, 64); if (lane >= o) incl += v; }
        float run = incl - tot;
        float* pa = cum + ((size_t)b * SEQ + lane * 32) * 64 + dir * 32 + r; float* pb = pa + 16;
#pragma unroll
        for (int k = 0; k < 32; ++k) { const float dt = xr[k]; const float la = dt * A, l2 = log2f(dt);
            if (dir == 0) { run += la; pa[(size_t)k * 64] = run * LOG2E; pb[(size_t)k * 64] = run * LOG2E - l2; }
            else { pa[(size_t)k * 64] = run * LOG2E; pb[(size_t)k * 64] = run * LOG2E + l2; run += la; } }
    }
}

#define MFMA16(a, b, c) __builtin_amdgcn_mfma_f32_16x16x32_bf16((a), (b), (c), 0, 0, 0)
__device__ __forceinline__ bf16x8 ld_frag16(const LAS bf16_t* p) { return *(const LAS bf16x8*)p; }
__device__ __forceinline__ bf16x8 ld_frag_split(const LAS bf16_t* p) {
    const u32x2 lo = *(const LAS u32x2*)p, hi = *(const LAS u32x2*)(p + 16); u32x4 v = (u32x4){lo.x, lo.y, hi.x, hi.y}; return __builtin_bit_cast(bf16x8, v); }
__device__ __forceinline__ bf16x8 pack_frag(const f32x4& a, const f32x4& b) {
    u32x4 v = (u32x4){cvt_pk_bf16(a[0], a[1]), cvt_pk_bf16(a[2], a[3]), cvt_pk_bf16(b[0], b[1]), cvt_pk_bf16(b[2], b[3])}; return __builtin_bit_cast(bf16x8, v); }

template <int DK, int DK1, int DV, int QT, int PD>
__device__ __forceinline__ void attn_item(LAS unsigned char* lds, const bf16_t* Q, int ldq, const bf16_t* K1, int ldk1, const bf16_t* K2, int ldk2,
                                          const bf16_t* Vt, long ldvt, int nkeys, bf16_t* O, int ldo, const float* osc) {
    constexpr int KS = DK / 32, DT = DV / 16, KSTR = DK + 8, VSTR = 136, BUFE = 128 * KSTR + DV * VSTR;
    LAS bf16_t* Ks0 = (LAS bf16_t*)lds; LAS bf16_t* Vs0 = Ks0 + 128 * KSTR;
    const int tid = opaque_tid(), lane = tid & 63, wv = tid >> 6, i = lane & 15, quad = lane >> 4;
    bf16x8 qf[QT][KS];
#pragma unroll
    for (int qt = 0; qt < QT; ++qt)
#pragma unroll
        for (int ks = 0; ks < KS; ++ks) qf[qt][ks] = *(const bf16x8*)(Q + (size_t)(wv * 16 * QT + qt * 16 + i) * ldq + ks * 32 + quad * 8);
    f32x4 acc_o[DT][QT]; float mrow[QT], lsum[QT];
#pragma unroll
    for (int qt = 0; qt < QT; ++qt) { mrow[qt] = -INFINITY; lsum[qt] = 0.f;
#pragma unroll
        for (int d = 0; d < DT; ++d) acc_o[d][qt] = (f32x4){0.f, 0.f, 0.f, 0.f}; }
    constexpr int KCH = DK / 8, NKQ = (128 * KCH + 511) / 512, NVQ = (DV * 16 + 511) / 512;
    static_assert(128 * KCH == NKQ * 512 && DV * 16 == NVQ * 512, "tile chunks must divide evenly over 512 threads");
    u32x4 pK[NKQ], pV[NVQ];
    typedef const __attribute__((address_space(1))) bf16_t* gbf16p;
    gbf16p kptr[NKQ]; unsigned kstr[NKQ];
#pragma unroll
    for (int q = 0; q < NKQ; ++q) { const int c = tid + q * 512, key = c / KCH, dc = (c % KCH) * 8;
        if (dc < DK1) { kptr[q] = (gbf16p)(K1 + (size_t)key * ldk1 + dc); kstr[q] = (unsigned)ldk1 * 128u; } else { kptr[q] = (gbf16p)(K2 + (size_t)key * ldk2 + (dc - DK1)); kstr[q] = (unsigned)ldk2 * 128u; } }
    const unsigned voff = (unsigned)((tid >> 4) * ldvt + (tid & 15) * 8);
#define ATT_LOAD(k0_) do { \
        _Pragma("unroll") for (int q = 0; q < NKQ; ++q) { pK[q] = *(const __attribute__((address_space(1))) u32x4*)kptr[q]; kptr[q] += kstr[q]; } \
        _Pragma("unroll") for (int q = 0; q < NVQ; ++q) pV[q] = *(const u32x4*)((Vt + (size_t)q * 32 * ldvt + (k0_)) + voff); } while (0)
#define ATT_STORE(B_) do { \
        _Pragma("unroll") for (int q = 0; q < NKQ; ++q) { const int c = tid + q * 512; *(LAS u32x4*)(Ks0 + (B_) * BUFE + (c / KCH) * KSTR + (c % KCH) * 8) = pK[q]; } \
        _Pragma("unroll") for (int q = 0; q < NVQ; ++q) { const int c = tid + q * 512; *(LAS u32x4*)(Vs0 + (B_) * BUFE + (c >> 4) * VSTR + (c & 15) * 8) = pV[q]; } } while (0)
#define ATT_QK(SC, KOFF) do { _Pragma("unroll") for (int kt = 0; kt < 4; ++kt) { \
            _Pragma("unroll") for (int qt = 0; qt < QT; ++qt) SC[kt][qt] = (f32x4){0.f, 0.f, 0.f, 0.f}; \
            _Pragma("unroll") for (int ks = 0; ks < KS; ++ks) { const bf16x8 kf = ld_frag16(Ks + ((KOFF) + kt * 16 + i) * KSTR + ks * 32 + quad * 8); \
                _Pragma("unroll") for (int qt = 0; qt < QT; ++qt) SC[kt][qt] = MFMA16(kf, qf[qt][ks], SC[kt][qt]); } } } while (0)
#define ATT_SOFTMAX_PV(SC, KOFF) do { bf16x8 pf[2][QT]; \
        _Pragma("unroll") for (int qt = 0; qt < QT; ++qt) { float mx = -INFINITY; \
            _Pragma("unroll") for (int kt = 0; kt < 4; ++kt) _Pragma("unroll") for (int j = 0; j < 4; ++j) mx = fmaxf(mx, SC[kt][qt][j]); \
            mx = fmaxf(mx, shfl_xor_f(mx, 16)); mx = fmaxf(mx, shfl_xor_f(mx, 32)); \
            const float mn = fmaxf(mrow[qt], mx), alpha = fexp2(mrow[qt] - mn); mrow[qt] = mn; float ls = 0.f; \
            _Pragma("unroll") for (int kt = 0; kt < 4; ++kt) _Pragma("unroll") for (int j = 0; j < 4; ++j) { const float p = fexp2(SC[kt][qt][j] - mn); SC[kt][qt][j] = p; ls += p; } \
            lsum[qt] = lsum[qt] * alpha + ls; \
            _Pragma("unroll") for (int d = 0; d < DT; ++d) acc_o[d][qt] *= alpha; \
            pf[0][qt] = pack_frag(SC[0][qt], SC[1][qt]); pf[1][qt] = pack_frag(SC[2][qt], SC[3][qt]); } \
        _Pragma("unroll") for (int u = 0; u < 2; ++u) _Pragma("unroll") for (int d = 0; d < DT; ++d) { const bf16x8 vf = ld_frag_split(Vs + (d * 16 + i) * VSTR + (KOFF) + u * 32 + quad * 4); \
            _Pragma("unroll") for (int qt = 0; qt < QT; ++qt) acc_o[d][qt] = MFMA16(vf, pf[u][qt], acc_o[d][qt]); } } while (0)
    const int nt = nkeys >> 7;
    ATT_LOAD(0);
    __syncthreads();
    ATT_STORE(0);
    __syncthreads();
    if (1 < nt) ATT_LOAD(128);
    for (int t = 0; t < nt; ++t) {
        const int bsel = t & 1; LAS bf16_t* Ks = Ks0 + bsel * BUFE; LAS bf16_t* Vs = Vs0 + bsel * BUFE;
        if (t + 1 < nt) { ATT_STORE(bsel ^ 1); if (t + 2 < nt) ATT_LOAD((t + 2) * 128); }
        f32x4 sca[4][QT], scb[4][QT];
        ATT_QK(sca, 0); ATT_QK(scb, 64);
        ATT_SOFTMAX_PV(sca, 0);
        ATT_SOFTMAX_PV(scb, 64);
        __syncthreads();
    }
#pragma unroll
    for (int qt = 0; qt < QT; ++qt) { float l = lsum[qt]; l += shfl_xor_f(l, 16); l += shfl_xor_f(l, 32); float inv = frcp(l);
        if (osc) inv *= sqrtf(ss_sum(osc, (size_t)(wv * 16 * QT + qt * 16 + i), 16) * (1.0f / 1024) + EPS);
        bf16_t* op = O + (size_t)(wv * 16 * QT + qt * 16 + i) * ldo + quad * 4;
#pragma unroll
        for (int d = 0; d < DT; ++d) { const f32x4 v = acc_o[d][qt] * inv; u32x2 p; p.x = cvt_pk_bf16(v[0], v[1]); p.y = cvt_pk_bf16(v[2], v[3]); *(u32x2*)(op + d * 16) = p; } }
#undef ATT_LOAD
#undef ATT_STORE
#undef ATT_QK
#undef ATT_SOFTMAX_PV
}

__device__ __forceinline__ void xa_item(LAS unsigned char* lds, const bf16_t* Q, const bf16_t* K, const bf16_t* Vt, bf16_t* O) {
    constexpr int KSTR = 264, VSTR = 72, LDQ = 1024, LDK = 1024, LDO = 1024; constexpr long LDV = TMEM;
    LAS bf16_t* Ks = (LAS bf16_t*)lds; LAS bf16_t* Vs = (LAS bf16_t*)lds;
    const int tid = opaque_tid(), lane = tid & 63, wv = tid >> 6, i = lane & 15, quad = lane >> 4;
    bf16x8 qf[2][8];
#pragma unroll
    for (int qt = 0; qt < 2; ++qt)
#pragma unroll
        for (int ks = 0; ks < 8; ++ks) qf[qt][ks] = *(const bf16x8*)(Q + (size_t)(wv * 32 + qt * 16 + i) * LDQ + ks * 32 + quad * 8);
    u32x4 pK[4], pV[2];
    const unsigned koff = (unsigned)((tid >> 5) * LDK + (tid & 31) * 8), voff = (unsigned)((tid >> 3) * LDV + (tid & 7) * 8);
#define XA_LOADK(t_) do { _Pragma("unroll") for (int q = 0; q < 4; ++q) pK[q] = *(const u32x4*)((K + (size_t)((t_) * 64 + q * 16) * LDK) + koff); } while (0)
#define XA_LOADV(h_, t_) do { _Pragma("unroll") for (int q = 0; q < 2; ++q) pV[q] = *(const u32x4*)((Vt + (size_t)((h_) * 128 + q * 64) * LDV + (t_) * 64) + voff); } while (0)
    f32x4 sc[16][2];
#pragma unroll
    for (int k = 0; k < 16; ++k) { sc[k][0] = (f32x4){0.f, 0.f, 0.f, 0.f}; sc[k][1] = (f32x4){0.f, 0.f, 0.f, 0.f}; }
    XA_LOADK(0);
#pragma unroll
    for (int t = 0; t < 4; ++t) {
        __syncthreads();
#pragma unroll
        for (int q = 0; q < 4; ++q) { const int c = tid + q * 512; *(LAS u32x4*)(Ks + (c >> 5) * KSTR + (c & 31) * 8) = pK[q]; }
        __syncthreads();
        if (t < 3) XA_LOADK(t + 1); else XA_LOADV(0, 0);
#pragma unroll
        for (int kt = 0; kt < 4; ++kt)
#pragma unroll
            for (int ks = 0; ks < 8; ++ks) { const bf16x8 kf = ld_frag16(Ks + (kt * 16 + i) * KSTR + ks * 32 + quad * 8);
                sc[t * 4 + kt][0] = MFMA16(kf, qf[0][ks], sc[t * 4 + kt][0]); sc[t * 4 + kt][1] = MFMA16(kf, qf[1][ks], sc[t * 4 + kt][1]); }
    }
    bf16x8 pf[8][2]; float linv[2];
#pragma unroll
    for (int qt = 0; qt < 2; ++qt) {
        float mx = -INFINITY;
#pragma unroll
        for (int k = 0; k < 16; ++k)
#pragma unroll
            for (int j = 0; j < 4; ++j) mx = fmaxf(mx, sc[k][qt][j]);
        mx = fmaxf(mx, shfl_xor_f(mx, 16)); mx = fmaxf(mx, shfl_xor_f(mx, 32));
        float ls = 0.f;
#pragma unroll
        for (int k = 0; k < 16; ++k)
#pragma unroll
            for (int j = 0; j < 4; ++j) { const float p = fexp2(sc[k][qt][j] - mx); sc[k][qt][j] = p; ls += p; }
        ls += shfl_xor_f(ls, 16); ls += shfl_xor_f(ls, 32); linv[qt] = frcp(ls);
#pragma unroll
        for (int u = 0; u < 8; ++u) pf[u][qt] = pack_frag(sc[2 * u][qt], sc[2 * u + 1][qt]);
    }
#pragma unroll
    for (int h = 0; h < 2; ++h) {
        f32x4 acc_o[8][2];
#pragma unroll
        for (int d = 0; d < 8; ++d) { acc_o[d][0] = (f32x4){0.f, 0.f, 0.f, 0.f}; acc_o[d][1] = (f32x4){0.f, 0.f, 0.f, 0.f}; }
#pragma unroll
        for (int t = 0; t < 4; ++t) {
            __syncthreads();
#pragma unroll
            for (int q = 0; q < 2; ++q) { const int c = tid + q * 512; *(LAS u32x4*)(Vs + (c >> 3) * VSTR + (c & 7) * 8) = pV[q]; }
            __syncthreads();
            if (t < 3) XA_LOADV(h, t + 1); else if (h == 0) XA_LOADV(1, 0);
#pragma unroll
            for (int u = 0; u < 2; ++u)
#pragma unroll
                for (int d = 0; d < 8; ++d) { const bf16x8 vf = ld_frag_split(Vs + (d * 16 + i) * VSTR + u * 32 + quad * 4);
                    acc_o[d][0] = MFMA16(vf, pf[t * 2 + u][0], acc_o[d][0]); acc_o[d][1] = MFMA16(vf, pf[t * 2 + u][1], acc_o[d][1]); }
        }
#pragma unroll
        for (int qt = 0; qt < 2; ++qt) { bf16_t* op = O + (size_t)(wv * 32 + qt * 16 + i) * LDO + h * 128 + quad * 4;
#pragma unroll
            for (int d = 0; d < 8; ++d) { const f32x4 v = acc_o[d][qt] * linv[qt]; u32x2 p; p.x = cvt_pk_bf16(v[0], v[1]); p.y = cvt_pk_bf16(v[2], v[3]); *(u32x2*)(op + d * 16) = p; } }
    }
#undef XA_LOADK
#undef XA_LOADV
}

template <int NH>
__device__ __forceinline__ void ssd_item(LAS unsigned char* lds, const Args& a, int e, int b, int g, int hh, int lb, float* ss_g, bool commit) {
    static_assert(NH == 4, "layout below assumes 4 heads per item");
    constexpr int BSTR = 136, XSTR = 72;
    unsigned char* scr = a.ws + OFF_SCR;
    const bf16_t* bcc = (const bf16_t*)(scr + S_BCC); const bf16_t* xT = (const bf16_t*)(scr + S_XT); bf16_t* Z = (bf16_t*)(scr + S_Z);
    const float* cum = (const float*)(scr + S_CUM);
    const float* Dp = (const float*)a.in[21] + e * 16;
    LAS bf16_t* Bs = (LAS bf16_t*)lds; LAS bf16_t* Xs = Bs + 64 * BSTR; LAS float* aFs = (LAS float*)(Xs + NH * 64 * XSTR); LAS float* aBs = aFs + 64 * NH; LAS float* F2 = aBs + 64 * NH;
    const int tid = opaque_tid(), lane = tid & 63, wv = tid >> 6, i = lane & 15, quad = lane >> 4;
    LAS float* F2w = F2 + wv * (64 * NH);
    const int h0 = g * 8 + hh * NH, l0 = lb * 128, lg = l0 + wv * 16 + i, st_d = (l0 + wv * 16) >> 6;
    const size_t trow = (size_t)b * SEQ + lg;
    bf16x8 cf[4];
#pragma unroll
    for (int ks = 0; ks < 4; ++ks) cf[ks] = *(const bf16x8*)(bcc + trow * 512 + 256 + g * 128 + ks * 32 + quad * 8);
    float refF[NH], refB[NH];
    const float* crow = cum + trow * 64 + h0;
#pragma unroll
    for (int r = 0; r < NH; ++r) { const float c = crow[r], ee = crow[32 + r];
        refF[r] = __int_as_float(__builtin_amdgcn_readlane(__float_as_int(c), 0)); refB[r] = __int_as_float(__builtin_amdgcn_readlane(__float_as_int(ee), 15)); }
    f32x4 acc_o[NH][4]; float f1b[NH];
#pragma unroll
    for (int r = 0; r < NH; ++r)
#pragma unroll
        for (int pt = 0; pt < 4; ++pt) acc_o[r][pt] = (f32x4){0.f, 0.f, 0.f, 0.f};
#pragma unroll
    for (int r = 0; r < NH; ++r) f1b[r] = fexp2(refB[r] - crow[32 + r]);
    u32x4 pB[2], pX[4]; float pF = 0.f, pBk = 0.f;
    const bf16_t* bsrc = bcc + ((size_t)b * SEQ) * 512 + g * 128; const bf16_t* xsrc = xT + ((size_t)b * 1024 + h0 * 64) * SEQ;
#define SSD_LOAD(s0_) do { \
        _Pragma("unroll") for (int q = 0; q < 2; ++q) pB[q] = *(const u32x4*)((bsrc + (size_t)((s0_) + q * 32) * 512) + boff); \
        _Pragma("unroll") for (int q = 0; q < 4; ++q) pX[q] = *(const u32x4*)((xsrc + (size_t)q * 64 * SEQ + (s0_)) + xoff); \
        if (tid < 64 * NH) { const float* ap = cum + ((size_t)b * SEQ + (s0_) + (tid >> 2)) * 64 + h0 + (tid & 3); pF = ap[16]; pBk = ap[48]; } } while (0)
    const unsigned boff = (unsigned)((tid >> 4) * 512 + (tid & 15) * 8), xoff = (unsigned)((tid >> 3) * SEQ + (tid & 7) * 8);
    SSD_LOAD(0);
    for (int st = 0; st < SEQ / 64; ++st) {
        const int s0 = st * 64;
        __syncthreads();
#pragma unroll
        for (int q = 0; q < 2; ++q) { const int c = tid + q * 512, s = c >> 4, nc = (c & 15) * 8; *(LAS u32x4*)(Bs + s * BSTR + nc) = pB[q]; }
#pragma unroll
        for (int q = 0; q < 4; ++q) { const int c = tid + q * 512, row = c >> 3, kc = (c & 7) * 8; *(LAS u32x4*)(Xs + row * XSTR + kc) = pX[q]; }
        if (tid < 64 * NH) { aFs[tid] = pF; aBs[tid] = pBk; }
        __syncthreads();
        if (st + 1 < SEQ / 64) SSD_LOAD(s0 + 64);
        f32x4 cb[4];
#pragma unroll
        for (int kt = 0; kt < 4; ++kt) { cb[kt] = (f32x4){0.f, 0.f, 0.f, 0.f};
#pragma unroll
            for (int ks = 0; ks < 4; ++ks) cb[kt] = MFMA16(ld_frag16(Bs + (kt * 16 + i) * BSTR + ks * 32 + quad * 8), cf[ks], cb[kt]); }
        if (st == st_d) {
#pragma unroll
            for (int r = 0; r < NH; ++r) { const float f1 = fexp2(crow[r] - refF[r]);
#pragma unroll
                for (int pt = 0; pt < 4; ++pt) acc_o[r][pt] *= f1; }
#pragma unroll
            for (int r = 0; r < NH; ++r) {
                const float clr = crow[r], elr = crow[32 + r], ddr = Dp[h0 + r];
                f32x4 w[4];
#pragma unroll
                for (int kt = 0; kt < 4; ++kt)
#pragma unroll
                    for (int j = 0; j < 4; ++j) { const int sl = kt * 16 + quad * 4 + j, sg = s0 + sl; const float af = aFs[sl * NH + r], ab = aBs[sl * NH + r];
                        const float argf = clr - af, argb = ab - elr;
                        float v;
                        if (sg == lg) v = cb[kt][j] * (fexp2(argf) + fexp2(argb)) + ddr;
                        else v = cb[kt][j] * fexp2(sg < lg ? argf : argb);
                        w[kt][j] = v; }
                const bf16x8 p0 = pack_frag(w[0], w[1]), p1 = pack_frag(w[2], w[3]);
#pragma unroll
                for (int pt = 0; pt < 4; ++pt) {
                    acc_o[r][pt] = MFMA16(ld_frag_split(Xs + (r * 64 + pt * 16 + i) * XSTR + quad * 4), p0, acc_o[r][pt]);
                    acc_o[r][pt] = MFMA16(ld_frag_split(Xs + (r * 64 + pt * 16 + i) * XSTR + 32 + quad * 4), p1, acc_o[r][pt]); }
            }
        } else {
            const bool lower = st < st_d;
            { const f32x4 av = lower ? *(const LAS f32x4*)(aFs + lane * NH) : *(const LAS f32x4*)(aBs + lane * NH);
#pragma unroll
              for (int r = 0; r < NH; ++r) F2w[r * 64 + lane] = lower ? fexp2(refF[r] - av[r]) : fexp2(av[r] - refB[r]); }
            asm volatile("s_waitcnt lgkmcnt(0)" ::: "memory");
#define SSD_OFFDIAG(ACC, F1) do { _Pragma("unroll") for (int r = 0; r < NH; ++r) { bf16x8 p0, p1; \
                { const f32x4 w0 = cb[0] * *(const LAS f32x4*)(F2w + r * 64 + quad * 4) F1, w1 = cb[1] * *(const LAS f32x4*)(F2w + r * 64 + 16 + quad * 4) F1; p0 = pack_frag(w0, w1); } \
                { const f32x4 w2 = cb[2] * *(const LAS f32x4*)(F2w + r * 64 + 32 + quad * 4) F1, w3 = cb[3] * *(const LAS f32x4*)(F2w + r * 64 + 48 + quad * 4) F1; p1 = pack_frag(w2, w3); } \
                _Pragma("unroll") for (int pt = 0; pt < 4; ++pt) { \
                    ACC[r][pt] = MFMA16(ld_frag_split(Xs + (r * 64 + pt * 16 + i) * XSTR + quad * 4), p0, ACC[r][pt]); \
                    ACC[r][pt] = MFMA16(ld_frag_split(Xs + (r * 64 + pt * 16 + i) * XSTR + 32 + quad * 4), p1, ACC[r][pt]); } } } while (0)
            if (lower) SSD_OFFDIAG(acc_o, ); else SSD_OFFDIAG(acc_o, * f1b[r]);
#undef SSD_OFFDIAG
        }
    }
#undef SSD_LOAD
    float ss = 0.f;
#pragma unroll
    for (int r = 0; r < NH; ++r) {
#pragma unroll
        for (int pt = 0; pt < 4; ++pt) { const f32x4 yv = acc_o[r][pt];
            bf16_t* zp = Z + trow * 1024 + (h0 + r) * 64 + pt * 16 + quad * 4; const u32x2 zv = *(const u32x2*)zp;
            const float y0 = yv[0] * silu_f(bflo(zv.x)), y1 = yv[1] * silu_f(bfhi(zv.x)), y2 = yv[2] * silu_f(bflo(zv.y)), y3 = yv[3] * silu_f(bfhi(zv.y));
            ss += y0 * y0 + y1 * y1 + y2 * y2 + y3 * y3; u32x2 o; o.x = cvt_pk_bf16(y0, y1); o.y = cvt_pk_bf16(y2, y3); if (commit) *(u32x2*)zp = o; } }
    ss += shfl_xor_f(ss, 16); ss += shfl_xor_f(ss, 32);
    if (quad == 0 && commit) { float* gp = ss_g + trow * 16 + g * 2 + hh; gp[0] = ss; gp[4] = 0.f; gp[8] = 0.f; gp[12] = 0.f; }
}

__device__ __forceinline__ void ssd_item2(LAS unsigned char* lds, const Args& a, int e, int b, int g, int hq, int lb, float* ss_g, bool commit) {
    constexpr int NH = 2, BSTR = 136, XSTR = 72;
    unsigned char* scr = a.ws + OFF_SCR;
    const bf16_t* bcc = (const bf16_t*)(scr + S_BCC); const bf16_t* xT = (const bf16_t*)(scr + S_XT); bf16_t* Z = (bf16_t*)(scr + S_Z);
    const float* cum = (const float*)(scr + S_CUM);
    const float* Dp = (const float*)a.in[21] + e * 16;
    LAS bf16_t* Bs = (LAS bf16_t*)lds; LAS bf16_t* Xs = Bs + 64 * BSTR; LAS float* aFs = (LAS float*)(Xs + NH * 64 * XSTR); LAS float* aBs = aFs + 64 * NH; LAS float* F2 = aBs + 64 * NH;
    const int tid = opaque_tid(), lane = tid & 63, wv = tid >> 6, i = lane & 15, quad = lane >> 4;
    LAS float* F2w = F2 + wv * (64 * NH);
    const int h0 = g * 8 + hq * NH, l0 = lb * 256 + wv * 32, st_d = l0 >> 6;
    const size_t trow0 = (size_t)b * SEQ + l0 + i;
    bf16x8 cf[2][4];
#pragma unroll
    for (int qt = 0; qt < 2; ++qt)
#pragma unroll
        for (int ks = 0; ks < 4; ++ks) cf[qt][ks] = *(const bf16x8*)(bcc + (trow0 + 16 * qt) * 512 + 256 + g * 128 + ks * 32 + quad * 8);
    const float* crow = cum + trow0 * 64 + h0;
    float refF[NH], refB[NH], f1b[2][NH];
#pragma unroll
    for (int r = 0; r < NH; ++r) { const float c = crow[r], ee = crow[16 * 64 + 32 + r];
        refF[r] = __int_as_float(__builtin_amdgcn_readlane(__float_as_int(c), 0)); refB[r] = __int_as_float(__builtin_amdgcn_readlane(__float_as_int(ee), 15));
        f1b[0][r] = fexp2(refB[r] - crow[32 + r]); f1b[1][r] = fexp2(refB[r] - ee); }
    f32x4 acc_o[NH][4][2];
#pragma unroll
    for (int r = 0; r < NH; ++r)
#pragma unroll
        for (int pt = 0; pt < 4; ++pt) { acc_o[r][pt][0] = (f32x4){0.f, 0.f, 0.f, 0.f}; acc_o[r][pt][1] = (f32x4){0.f, 0.f, 0.f, 0.f}; }
    u32x4 pB[2], pX[2]; float pF = 0.f, pBk = 0.f;
    const bf16_t* bsrc = bcc + ((size_t)b * SEQ) * 512 + g * 128; const bf16_t* xsrc = xT + ((size_t)b * 1024 + h0 * 64) * SEQ;
    const unsigned boff = (unsigned)((tid >> 4) * 512 + (tid & 15) * 8), xoff = (unsigned)((tid >> 3) * SEQ + (tid & 7) * 8);
#define SSD_LOAD(s0_) do { \
        _Pragma("unroll") for (int q = 0; q < 2; ++q) pB[q] = *(const u32x4*)((bsrc + (size_t)((s0_) + q * 32) * 512) + boff); \
        _Pragma("unroll") for (int q = 0; q < 2; ++q) pX[q] = *(const u32x4*)((xsrc + (size_t)q * 64 * SEQ + (s0_)) + xoff); \
        if (tid < 64 * NH) { const float* ap = cum + ((size_t)b * SEQ + (s0_) + (tid >> 1)) * 64 + h0 + (tid & 1); pF = ap[16]; pBk = ap[48]; } } while (0)
    SSD_LOAD(0);
    for (int st = 0; st < SEQ / 64; ++st) {
        const int s0 = st * 64;
        __syncthreads();
#pragma unroll
        for (int q = 0; q < 2; ++q) { const int c = tid + q * 512, s = c >> 4, nc = (c & 15) * 8; *(LAS u32x4*)(Bs + s * BSTR + nc) = pB[q]; }
#pragma unroll
        for (int q = 0; q < 2; ++q) { const int c = tid + q * 512, row = c >> 3, kc = (c & 7) * 8; *(LAS u32x4*)(Xs + row * XSTR + kc) = pX[q]; }
        if (tid < 64 * NH) { aFs[tid] = pF; aBs[tid] = pBk; }
        __syncthreads();
        if (st + 1 < SEQ / 64) SSD_LOAD(s0 + 64);
        const bool diag = (st == st_d), lower = st < st_d; bool live0 = true, live1 = true;
        if (diag) {
#pragma unroll
            for (int r = 0; r < NH; ++r)
#pragma unroll
                for (int qt = 0; qt < 2; ++qt) { const float f1 = fexp2(crow[qt * 16 * 64 + r] - refF[r]);
#pragma unroll
                    for (int pt = 0; pt < 4; ++pt) acc_o[r][pt][qt] *= f1; }
        } else {
            const float av0 = lower ? aFs[lane * NH] : aBs[lane * NH], av1 = lower ? aFs[lane * NH + 1] : aBs[lane * NH + 1];
            const float f20 = lower ? fexp2(refF[0] - av0) : fexp2(av0 - refB[0]), f21 = lower ? fexp2(refF[1] - av1) : fexp2(av1 - refB[1]);
            F2w[lane] = f20; F2w[64 + lane] = f21;
            live0 = __builtin_amdgcn_ballot_w64(f20 != 0.f) != 0ull; live1 = __builtin_amdgcn_ballot_w64(f21 != 0.f) != 0ull;
            asm volatile("s_waitcnt lgkmcnt(0)" ::: "memory");
        }
        if (live0 || live1) {
#pragma unroll
        for (int u = 0; u < 2; ++u) {
            f32x4 cb[2][2];
#pragma unroll
            for (int kk = 0; kk < 2; ++kk) { cb[kk][0] = (f32x4){0.f, 0.f, 0.f, 0.f}; cb[kk][1] = (f32x4){0.f, 0.f, 0.f, 0.f};
#pragma unroll
                for (int ks = 0; ks < 4; ++ks) { const bf16x8 bf = ld_frag16(Bs + ((2 * u + kk) * 16 + i) * BSTR + ks * 32 + quad * 8);
                    cb[kk][0] = MFMA16(bf, cf[0][ks], cb[kk][0]); cb[kk][1] = MFMA16(bf, cf[1][ks], cb[kk][1]); } }
#pragma unroll
            for (int r = 0; r < NH; ++r) {
                if (!(r == 0 ? live0 : live1)) continue;
                bf16x8 p[2];
                if (diag) {
                    const float ddr = Dp[h0 + r];
#pragma unroll
                    for (int qt = 0; qt < 2; ++qt) { const float clr = crow[qt * 16 * 64 + r], elr = crow[qt * 16 * 64 + 32 + r]; const int lg = l0 + 16 * qt + i; f32x4 w[2];
#pragma unroll
                        for (int kk = 0; kk < 2; ++kk)
#pragma unroll
                            for (int j = 0; j < 4; ++j) { const int sl = (2 * u + kk) * 16 + quad * 4 + j, sg = s0 + sl; const float af = aFs[sl * NH + r], ab = aBs[sl * NH + r];
                                const float argf = clr - af, argb = ab - elr; float v;
                                if (sg == lg) v = cb[kk][qt][j] * (fexp2(argf) + fexp2(argb)) + ddr;
                                else v = cb[kk][qt][j] * fexp2(sg < lg ? argf : argb);
                                w[kk][j] = v; }
                        p[qt] = pack_frag(w[0], w[1]); }
                } else {
                    const f32x4 fa = *(const LAS f32x4*)(F2w + r * 64 + u * 32 + quad * 4), fb = *(const LAS f32x4*)(F2w + r * 64 + u * 32 + 16 + quad * 4);
#pragma unroll
                    for (int qt = 0; qt < 2; ++qt) { const float fs = lower ? 1.0f : f1b[qt][r]; p[qt] = pack_frag(cb[0][qt] * fa * fs, cb[1][qt] * fb * fs); }
                }
#pragma unroll
                for (int pt = 0; pt < 4; ++pt) { const bf16x8 xf = ld_frag_split(Xs + (r * 64 + pt * 16 + i) * XSTR + u * 32 + quad * 4);
                    acc_o[r][pt][0] = MFMA16(xf, p[0], acc_o[r][pt][0]); acc_o[r][pt][1] = MFMA16(xf, p[1], acc_o[r][pt][1]); }
            }
        }
        }
    }
#undef SSD_LOAD
#pragma unroll
    for (int qt = 0; qt < 2; ++qt) { float ss = 0.f; const size_t trow = trow0 + 16 * qt;
#pragma unroll
        for (int r = 0; r < NH; ++r)
#pragma unroll
            for (int pt = 0; pt < 4; ++pt) { const f32x4 yv = acc_o[r][pt][qt];
                bf16_t* zp = Z + trow * 1536 + (h0 + r) * 64 + pt * 16 + quad * 4; const u32x2 zv = *(const u32x2*)zp;
                const float y0 = yv[0] * silu_f(bflo(zv.x)), y1 = yv[1] * silu_f(bfhi(zv.x)), y2 = yv[2] * silu_f(bflo(zv.y)), y3 = yv[3] * silu_f(bfhi(zv.y));
                ss += y0 * y0 + y1 * y1 + y2 * y2 + y3 * y3; u32x2 o; o.x = cvt_pk_bf16(y0, y1); o.y = cvt_pk_bf16(y2, y3); if (commit) *(u32x2*)zp = o; }
        ss += shfl_xor_f(ss, 16); ss += shfl_xor_f(ss, 32);
        if (quad == 0 && commit) { float* gp = ss_g + trow * 16 + g * 4 + hq; gp[0] = ss; gp[8] = 0.f; } }
}

__device__ void fnet_norm_T(const Args& a, int l, const float* rss, LAS unsigned char* lds) {
    const float* h = a.out; const float* w = (const float*)a.in[8] + l * DM; bf16_t* uT = (bf16_t*)(a.ws + OFF_SCR + S_UT);
    LAS bf16_t* tl = (LAS bf16_t*)lds; const int tid = opaque_tid();
    for (int trip = 0; ; ++trip) { const int it = xcd_item(trip, NB * 32 * 4); if (it < 0) break;
        const int b = it >> 7, st = (it >> 2) & 31, ct = it & 3, s0 = st * 64, c0 = ct * 256;
        { const int s = tid >> 3, cv = tid & 7; const size_t row = (size_t)b * SEQ + s0 + s;
          const float rs = rstd_of(ss_sum(rss, row, 16), 1.0f / DM);
          f32x4 v0[4], v1[4];
#pragma unroll
          for (int j = 0; j < 4; ++j) { const int ch = c0 + 64 * j + 8 * cv; v0[j] = *(const f32x4*)(h + row * DM + ch); v1[j] = *(const f32x4*)(h + row * DM + ch + 4); }
#pragma unroll
          for (int j = 0; j < 4; ++j) { const int ch = c0 + 64 * j + 8 * cv; const f32x4 w0 = *(const f32x4*)(w + ch), w1 = *(const f32x4*)(w + ch + 4);
              const f32x4 r0 = v0[j] * w0 * rs, r1 = v1[j] * w1 * rs;
              const unsigned p0 = cvt_pk_bf16(r0[0], r0[1]), p1 = cvt_pk_bf16(r0[2], r0[3]), p2 = cvt_pk_bf16(r1[0], r1[1]), p3 = cvt_pk_bf16(r1[2], r1[3]);
              LAS bf16_t* tp = tl + (64 * j + 8 * cv) * 72 + s;
              tp[0] = (bf16_t)(p0 & 0xffff); tp[72] = (bf16_t)(p0 >> 16); tp[144] = (bf16_t)(p1 & 0xffff); tp[216] = (bf16_t)(p1 >> 16);
              tp[288] = (bf16_t)(p2 & 0xffff); tp[360] = (bf16_t)(p2 >> 16); tp[432] = (bf16_t)(p3 & 0xffff); tp[504] = (bf16_t)(p3 >> 16); } }
        __syncthreads();
        { const int sv = tid & 7;
#pragma unroll
          for (int j = 0; j < 4; ++j) { const int ch = (tid >> 3) + 64 * j; const u32x4 v = *(const LAS u32x4*)(tl + ch * 72 + 8 * sv);
              *(u32x4*)(uT + ((size_t)b * 1024 + c0 + ch) * SEQ + s0 + 8 * sv) = v; } }
        __syncthreads();
    }
}
__device__ void final_norm(const Args& a, const float* rss) {
    const float* w = (const float*)a.in[4]; const int tid = opaque_tid(); const int lane = tid & 63, wv = tid >> 6;
    for (int rl = (int)(blockIdx.x >> 3) * 8 + wv; rl < T_TOK / 8; rl += (int)(gridDim.x >> 3) * 8) { const int r = (int)(blockIdx.x & 7) * (T_TOK / 8) + rl;
        const float rs = rstd_of(ss_sum(rss, (size_t)r, 16), 1.0f / DM); float* p = a.out + (size_t)r * DM + lane * 4;
#pragma unroll
        for (int k = 0; k < 4; ++k) { const f32x4 v = *(const f32x4*)(p + k * 256), wv4 = *(const f32x4*)(w + lane * 4 + k * 256); *(f32x4*)(p + k * 256) = v * wv4 * rs; }
    }
}


#define XB_TMO      128
#define XB_XCNT(j)  (256  + 64 * (j))
#define XB_XSUB(j)  (1280 + 64 * (j))
#define XB_XGEN(j)  (2304 + 64 * (j))
#define XB_TOP      3328
#define XB_TOPGEN   3392
#define XCD_BAR_WORDS 3456
#define XB_SPIN_CAP (1u << 18)
__device__ __forceinline__ unsigned xb_ld(unsigned* p)              { return __hip_atomic_load(p, __ATOMIC_RELAXED, __HIP_MEMORY_SCOPE_AGENT); }
__device__ __forceinline__ unsigned xb_add(unsigned* p, unsigned v) { return __hip_atomic_fetch_add(p, v, __ATOMIC_RELAXED, __HIP_MEMORY_SCOPE_AGENT); }
__device__ __forceinline__ unsigned xb_xcc_id() { return (unsigned)__builtin_amdgcn_s_getreg((3 << 11) | 20) & 0xFu; }
#define XB_SPIN(cond, bar) do { unsigned _sp = 0; while (cond) { __builtin_amdgcn_s_sleep(1); \
    if ((++_sp & 255u) == 0u) { if (xb_ld(&(bar)[XB_TMO])) break; if (_sp > XB_SPIN_CAP) { atomicAdd(&(bar)[XB_TMO], 1u); break; } } } } while (0)
struct XcdBarrier { unsigned* bar; unsigned x; volatile LAS unsigned* st; };
__device__ __forceinline__ XcdBarrier xcd_barrier_post(unsigned* bar, volatile LAS unsigned* st) {
    XcdBarrier b; b.bar = bar; b.x = xb_xcc_id(); b.st = st;
    if (threadIdx.x == 0) (void)xb_add(&bar[XB_XCNT(b.x)], 1u);
    return b;
}
__device__ __forceinline__ void xcd_barrier_complete(unsigned* bar, unsigned x, unsigned& nloc, unsigned& nx) {
    const unsigned G = gridDim.x * gridDim.y * gridDim.z;
    unsigned sum, cnt, mine, sp = 0u;
    for (;;) {
        sum = 0u; cnt = 0u; mine = 0u;
#pragma unroll
        for (unsigned j = 0; j < 16; ++j) { const unsigned c = xb_ld(&bar[XB_XCNT(j)]); sum += c; cnt += (c > 0u) ? 1u : 0u; mine = (j == x) ? c : mine; }
        if (sum == G) break;
        __builtin_amdgcn_s_sleep(1);
        if ((++sp & 255u) == 0u) { if (xb_ld(&bar[XB_TMO])) break; if (sp > XB_SPIN_CAP) { atomicAdd(&bar[XB_TMO], 1u); break; } }
    }
    nloc = mine > 0u ? mine : 1u; nx = cnt > 0u ? cnt : 1u;
}
__device__ __forceinline__ void xcd_barrier(const XcdBarrier& b) {
    asm volatile("s_waitcnt vmcnt(0)" ::: "memory");
    __syncthreads();
    if (threadIdx.x == 0) {
        unsigned* bar = b.bar;
        __builtin_amdgcn_s_waitcnt(0);
        unsigned nloc = b.st[0], nx = b.st[1];
        if (nloc == 0u) { xcd_barrier_complete(bar, b.x, nloc, nx); b.st[0] = nloc; b.st[1] = nx; }
        const unsigned old = xb_add(&bar[XB_XSUB(b.x)], 1u);
        const unsigned gen = old / nloc;
        if (old + 1u == (gen + 1u) * nloc) {
            __builtin_amdgcn_fence(__ATOMIC_RELEASE, "agent");
            asm volatile("s_waitcnt vmcnt(0)" ::: "memory");
            const unsigned og = xb_add(&bar[XB_TOP], 1u);
            const unsigned tg = og / nx;
            if (og + 1u == (tg + 1u) * nx) xb_add(&bar[XB_TOPGEN], 1u);
            else XB_SPIN(xb_ld(&bar[XB_TOPGEN]) == tg, bar);
            __builtin_amdgcn_fence(__ATOMIC_ACQUIRE, "agent");
            xb_add(&bar[XB_XGEN(b.x)], 1u);
            asm volatile("s_waitcnt vmcnt(0)" ::: "memory");
        } else {
            XB_SPIN(xb_ld(&bar[XB_XGEN(b.x)]) == gen, bar);
            __builtin_amdgcn_fence(__ATOMIC_ACQUIRE, "agent");
            asm volatile("s_waitcnt vmcnt(0)" ::: "memory");
        }
    }
    __syncthreads();
}

enum { PT_INIT = 0, PT_CONVERT, PT_FFN1A, PT_FFN1B, PT_E1, PT_E2, PT_E3, PT_E4, PT_E5, PT_O1, PT_O2, PT_O3, PT_X1, PT_X2, PT_X3, PT_FFN2A, PT_FFN2B, PT_FINAL };
enum { EK_NONE = -1, EK_SWIGLU = 0, EK_RESID, EK_STORE, EK_STORE_ROPE, EK_STORE_DFT, EK_WIN };
#ifndef DUP_MASK
#define DUP_MASK 0
#endif
#define PH(t, l) {t, l},
#define PHD(t, l) {t, l}, {(unsigned char)(((DUP_MASK >> (t)) & 1) ? (t) : 99), (unsigned char)((l) | 128)},
#define LAYER_EVEN(l) PHD(PT_FFN1A, l) PHD(PT_FFN1B, l) PHD(PT_E1, l) PHD(PT_E2, l) PHD(PT_E3, l) PHD(PT_E4, l) PHD(PT_E5, l) PHD(PT_X1, l) PHD(PT_X2, l) PHD(PT_X3, l) PHD(PT_FFN2A, l) PHD(PT_FFN2B, l)
#define LAYER_ODD(l) PHD(PT_FFN1A, l) PHD(PT_FFN1B, l) PHD(PT_O1, l) PHD(PT_O2, l) PHD(PT_O3, l) PHD(PT_X1, l) PHD(PT_X2, l) PHD(PT_X3, l) PHD(PT_FFN2A, l) PHD(PT_FFN2B, l)
#if DUP_MASK
__constant__ unsigned char PROG[][2] = { PH(PT_INIT, 0) LAYER_EVEN(0) PHD(PT_CONVERT, 1) LAYER_ODD(1) PHD(PT_CONVERT, 2) LAYER_EVEN(2) PHD(PT_CONVERT, 3) LAYER_ODD(3) PH(PT_FINAL, 0) };
#else
#undef PHD
#define PHD(t, l) {t, l},
__constant__ unsigned char PROG[][2] = { PH(PT_INIT, 0) LAYER_EVEN(0) PHD(PT_CONVERT, 1) LAYER_ODD(1) PHD(PT_CONVERT, 2) LAYER_EVEN(2) PHD(PT_CONVERT, 3) LAYER_ODD(3) PH(PT_FINAL, 0) };
#endif
constexpr int N_PHASES = (int)(sizeof(PROG) / 2);

struct EP { bf16_t* out; long ldc; const float* hin; bf16_t* hb; float* ss_out; const float* rss; int rss_w; float rs_inv; const float* css; int css_w; float cs_inv; long zoff; float alpha; };

__device__ __forceinline__ int build_job(const Args& a, int type, int l, int j, Gemm& g, EP& ep) {
    unsigned char* ws = a.ws; unsigned char* scr = ws + OFF_SCR;
    bf16_t* wb = (bf16_t*)(ws + OFF_WB); bf16_t* hb = (bf16_t*)(ws + OFF_HB);
    float* rowss = (float*)(ws + OFF_ROWSS); float* memss = (float*)(ws + OFF_MEMSS);
    float* h0 = rowss + RS_H0; float* h1 = rowss + RS_H1;
    float* ss_cq = rowss + RS_CQ; float* ss_ckv = rowss + RS_CKV; float* ss_g = rowss + RS_G;
    ep.out = nullptr; ep.ldc = 0; ep.hin = a.out; ep.hb = nullptr; ep.ss_out = nullptr; ep.rss = nullptr; ep.rss_w = 16; ep.rs_inv = 0.f; ep.css = nullptr; ep.css_w = 1; ep.cs_inv = 0.f; ep.zoff = 0; ep.alpha = 1.0f;
    switch (type) {
    case PT_FFN1A: case PT_FFN2A:
        if (j == 0) { g = mk_gemm(hb, DM, wb + (type == PT_FFN1A ? W_GU1 : W_GU2), DM, DM, 128, 22); ep.out = (bf16_t*)(scr + S_ACT); ep.rss = (type == PT_FFN1A ? h0 : h1); return EK_SWIGLU; }
        if (j == 1 && type == PT_FFN1A && (l & 1)) {
            g = mk_gemm(wb + W_FT, DM, (const bf16_t*)(ws + OFF_TCH), 256, 256, 4, 1); g.nZ = 8; g.zd = 4; g.sA1 = 0; g.sA2 = 256; g.sB1 = 65536; g.sB2 = 0;
            ep.out = wb + W_FOLD; ep.ldc = 2048; ep.zoff = 256; return EK_STORE; }
        return EK_NONE;
    case PT_FFN1B: case PT_FFN2B:
        if (j == 0) { g = mk_gemm((const bf16_t*)(scr + S_ACT), DFF, wb + (type == PT_FFN1B ? W_DN1 : W_DN2), DFF, DFF, 128, 4);
            ep.hin = (type == PT_FFN1B && l == 0) ? (const float*)a.in[0] : a.out; ep.hb = (type == PT_FFN2B && l == 3) ? nullptr : hb;     ep.ss_out = (type == PT_FFN1B ? h1 : h0); ep.alpha = 0.5f; return EK_RESID; }
        return EK_NONE;
    case PT_E1:
        if (j == 0) { g = mk_gemm(hb, DM, wb + W_IN, DM, DM, 128, 14); ep.rss = h1; ep.ss_out = ss_cq; ep.css = ss_ckv; return EK_WIN; }
        return EK_NONE;
    case PT_E3:
        if (j == 0) { g = mk_gemm((const bf16_t*)(scr + S_CQ), 512, wb + W_UQ, 512, 512, 128, 3); ep.out = (bf16_t*)(scr + S_QB); ep.ldc = 768; ep.rss = ss_cq; ep.rss_w = 8; ep.rs_inv = 1.0f / 512; return EK_STORE_ROPE; }
        if (j == 1) { g = mk_gemm((const bf16_t*)(scr + S_CKV), 256, wb + W_KN, 256, 256, 128, 2); ep.out = (bf16_t*)(scr + S_KN); ep.ldc = 512; ep.rss = ss_ckv; ep.rss_w = 4; ep.rs_inv = 1.0f / 256; return EK_STORE; }
        if (j == 2) { g = mk_gemm(wb + W_VV, 256, (const bf16_t*)(scr + S_CKV), 256, 256, 2, 128); ep.out = hb; ep.ldc = T_TOK; ep.css = ss_ckv; ep.css_w = 4; ep.cs_inv = 1.0f / 256; return EK_STORE; }
        return EK_NONE;
    case PT_E5:
        if (j == 0) { g = mk_gemm((const bf16_t*)(scr + S_Z), 1536, wb + W_OY, 1536, 1536, 128, 4); ep.rss = ss_g; ep.rss_w = 4; ep.rs_inv = 1.0f / 1024; ep.hb = hb; ep.ss_out = h0; return EK_RESID; }
        return EK_NONE;
    case PT_O2:
        if (j == 0) { g = mk_gemm((const bf16_t*)(ws + OFF_FSEQ), 2048, (const bf16_t*)(scr + S_UT), 2048, 2048, 8, 64); ep.out = (bf16_t*)(scr + S_YCS); ep.ldc = 2048; return EK_STORE_DFT; }
        return EK_NONE;
    case PT_O3:
        if (j == 0) { g = mk_gemm((const bf16_t*)(scr + S_YCS), 2048, wb + W_FOLD, 2048, 2048, 128, 4); ep.hb = hb; ep.ss_out = h0; return EK_RESID; }
        return EK_NONE;
    case PT_X1:
        if (j == 0) { g = mk_gemm(hb, DM, wb + W_Q, DM, DM, 128, 4); ep.out = (bf16_t*)(scr + S_XQ); ep.ldc = 1024; ep.rss = h0; ep.rs_inv = 1.0f / DM; return EK_STORE; }
        if (j == 1) { g = mk_gemm((const bf16_t*)(ws + OFF_MEMB), DM, wb + W_K, DM, DM, 16, 4); g.rot = 128; ep.out = (bf16_t*)(ws + OFF_KMEM); ep.ldc = 1024; ep.rss = memss; ep.rss_w = 1; ep.rs_inv = 1.0f / DM; return EK_STORE; }
        if (j == 2) { g = mk_gemm(wb + W_V, DM, (const bf16_t*)(ws + OFF_MEMB), DM, DM, 4, 16); g.rot = 64; ep.out = (bf16_t*)(ws + OFF_VTM); ep.ldc = TMEM; ep.css = memss; ep.cs_inv = 1.0f / DM; return EK_STORE; }
        return EK_NONE;
    case PT_X3:
        if (j == 0) { g = mk_gemm((const bf16_t*)(scr + S_XO), DM, wb + W_O, DM, DM, 128, 4); ep.hb = hb; ep.ss_out = h1; return EK_RESID; }
        return EK_NONE;
    default: return EK_NONE;
    }
}

__global__ void __launch_bounds__(512, 2) mk_fwd(Args a) {
    extern __shared__ __attribute__((aligned(16))) unsigned char shm[];
    LAS unsigned char* lds = (LAS unsigned char*)shm;
    unsigned char* ws = a.ws; unsigned char* scr = ws + OFF_SCR;
    const int* pos = (const int*)a.in[2];
    LAS unsigned* xst = (LAS unsigned*)(lds + LDS_XST);
    if (threadIdx.x == 0) { xst[0] = 0u; xst[1] = 0u; }
    __syncthreads();
    const XcdBarrier xb = xcd_barrier_post((unsigned*)(ws + OFF_BAR), (volatile LAS unsigned*)xst);
    for (int ph = a.ph_lo; ph < a.ph_hi && ph < N_PHASES; ++ph) {
        int type = PROG[ph][0]; const int l = PROG[ph][1] & 3, e = l >> 1; const bool dup = (PROG[ph][1] & 128) != 0;
#ifdef DBG_LAYERS
        if (l >= DBG_LAYERS && type != PT_FINAL) type = 99;
#endif
#ifdef DBG_SKIP_MIX
        if (type >= PT_E1 && type <= PT_O3) type = 99;
#endif
#ifdef DBG_SKIP_XA
        if (type >= PT_X1 && type <= PT_X3) type = 99;
#endif
        if (type == 99) continue;
        float* rowss = (float*)(ws + OFF_ROWSS);
        for (int j = 0; j < 3; ++j) {
            Gemm g; EP ep; const int ek = build_job(a, type, l, j, g, ep);
            if (ek == EK_NONE) break;
            if (dup) { ep.alpha = 0.f; ep.hin = a.out; }
            LAS float* rsc = (LAS float*)(lds + LDS_RSC) + threadIdx.x * 9; rsc[0] = __int_as_float(-1);
            switch (ek) {
            case EK_SWIGLU: { EpiSwiglu E; E.rsc = rsc; E.act = ep.out; E.rss = ep.rss; E.rss_w = ep.rss_w; gemm_phase(lds, g, E); } break;
            case EK_RESID: { EpiResid E; E.rsc = rsc; E.hin = ep.hin; E.hout = a.out; E.hb = ep.hb; E.ss_out = ep.ss_out; E.rss = ep.rss; E.rss_w = ep.rss_w; E.rss_inv_dim = ep.rs_inv; E.alpha = ep.alpha; gemm_phase(lds, g, E); } break;
            case EK_STORE: { EpiStore<0, false> E; E.rsc = rsc; E.out = ep.out; E.ldc = ep.ldc; E.rss = ep.rss; E.rss_w = ep.rss_w; E.rs_inv_dim = ep.rs_inv; E.css = ep.css; E.css_w = ep.css_w; E.cs_inv_dim = ep.cs_inv; E.zoff = ep.zoff; E.pos = nullptr; gemm_phase(lds, g, E); } break;
            case EK_STORE_ROPE: { EpiStore<0, true> E; E.rsc = rsc; E.out = ep.out; E.ldc = ep.ldc; E.rss = ep.rss; E.rss_w = ep.rss_w; E.rs_inv_dim = ep.rs_inv; E.css = nullptr; E.css_w = 1; E.cs_inv_dim = 0.f; E.zoff = 0; E.pos = pos; gemm_phase(lds, g, E); } break;
            case EK_STORE_DFT: { EpiStore<1, false> E; E.rsc = rsc; E.out = ep.out; E.ldc = ep.ldc; E.rss = nullptr; E.rss_w = 1; E.css_w = 1; E.rs_inv_dim = 0.f; E.css = nullptr; E.cs_inv_dim = 0.f; E.zoff = 0; E.pos = nullptr; gemm_phase(lds, g, E); } break;
            default: { EpiWin E; E.rsc = rsc; E.scr = scr; E.rss = ep.rss; E.rss_w = ep.rss_w; E.ss_cq = ep.ss_out; E.ss_ckv = (float*)ep.css; E.pos = pos; gemm_phase(lds, g, E); } break;
            }
        }
        switch (type) {
        case PT_INIT:
            rows_to_bf16((const float*)a.in[0], (bf16_t*)(ws + OFF_HB), rowss + RS_H0, T_TOK, 16);
            rows_to_bf16((const float*)a.in[1], (bf16_t*)(ws + OFF_MEMB), (float*)(ws + OFF_MEMSS), TMEM, 16);
            gen_tables(a);
            convert_layer(a, 0, (LAS float*)lds);
            break;
        case PT_CONVERT: convert_layer(a, l, (LAS float*)lds); break;
        case PT_E2: conv_phase(a, e, lds); break;
        case PT_E3:
            for (int trip = 0; ; ++trip) { const int it = xcd_item(trip, NB * 2 * 4 * 8); if (it < 0) break; const int b = it >> 6, g = (it >> 5) & 1, hq = ((it >> 3) + trip) & 3, lb = it & 7;
                ssd_item2(lds, a, e, b, g, hq, lb, rowss + RS_G, !dup); }
            break;
        case PT_E4:
            for (int trip = 0; ; ++trip) { const int it = xcd_item(trip, NB * 8 * 8); if (it < 0) break; const int b = it >> 6, hd = (it >> 3) & 7, qb = it & 7; const size_t r0 = (size_t)b * SEQ;
                attn_item<96, 64, 64, 2, 2>(lds, (const bf16_t*)(scr + S_QB) + (r0 + qb * 256) * 768 + hd * 96, 768,
                    (const bf16_t*)(scr + S_KN) + r0 * 512 + hd * 64, 512, (const bf16_t*)(scr + S_KROPE) + r0 * 32, 32,
                    (const bf16_t*)(ws + OFF_HB) + (size_t)(hd * 64) * T_TOK + r0, T_TOK, SEQ, (bf16_t*)(scr + S_Z) + (r0 + qb * 256) * 1536 + 1024 + hd * 64, 1536, rowss + RS_G + (r0 + qb * 256) * 16); }
            break;
        case PT_O1: fnet_norm_T(a, l, rowss + RS_H1, lds); break;
        case PT_X2:
            for (int trip = 0; ; ++trip) { const int it = xcd_item(trip, NB * 4 * 8); if (it < 0) break; const int b = it >> 5, hd = (it >> 3) & 3, qb = it & 7; const size_t r0 = (size_t)b * SEQ + qb * 256;
                xa_item(lds, (const bf16_t*)(scr + S_XQ) + r0 * 1024 + hd * 256, (const bf16_t*)(ws + OFF_KMEM) + (size_t)(b * NMEM) * 1024 + hd * 256,
                    (const bf16_t*)(ws + OFF_VTM) + (size_t)(hd * 256) * TMEM + b * NMEM, (bf16_t*)(scr + S_XO) + r0 * 1024 + hd * 256); }
            break;
        case PT_FINAL: final_norm(a, rowss + RS_H0); break;
        default: break;
        }
        if (ph + 1 < a.ph_hi && ph + 1 < N_PHASES) {
            if (ph == a.ph_lo) {
                asm volatile("s_waitcnt vmcnt(0) lgkmcnt(0)" ::: "memory");
                __syncthreads();
                if (threadIdx.x < 64) { __builtin_amdgcn_fence(__ATOMIC_RELEASE, "agent"); asm volatile("s_waitcnt vmcnt(0) lgkmcnt(0)" ::: "memory"); }
                cg::this_grid().sync();
                __builtin_amdgcn_fence(__ATOMIC_ACQUIRE, "agent");
                asm volatile("s_waitcnt vmcnt(0) lgkmcnt(0)" ::: "memory");
            } else xcd_barrier(xb);
        }
    }
}

extern "C" void kernel_launch(void* const* d_in, const int* in_sizes, int n_in, void* d_out, int out_size, void* d_ws, size_t ws_size, hipStream_t stream) {
    static int grid = 0;
    if (grid == 0) {
        if (n_in != 29 || ws_size < WS_NEED) { fprintf(stderr, "kernel_launch: need 29 inputs and %zu bytes of workspace; got %d, %zu\n", (size_t)WS_NEED, n_in, ws_size); grid = -1; return; }
        int dev = 0, cus = 0, per_cu = 0;
        hipGetDevice(&dev); hipDeviceGetAttribute(&cus, hipDeviceAttributeMultiprocessorCount, dev);
        if (hipFuncSetAttribute((const void*)mk_fwd, hipFuncAttributeMaxDynamicSharedMemorySize, LDS_BYTES) != hipSuccess) { fprintf(stderr, "kernel_launch: hipFuncSetAttribute failed\n"); grid = -1; return; }
        if (hipOccupancyMaxActiveBlocksPerMultiprocessor(&per_cu, (const void*)mk_fwd, 512, LDS_BYTES) != hipSuccess || per_cu < 1) { fprintf(stderr, "kernel_launch: occupancy query says %d\n", per_cu); per_cu = 1; }
        (void)hipGetLastError();
        grid = cus;
    }
    if (grid < 0) return;
    Args a{};
    for (int i = 0; i < 29; ++i) a.in[i] = d_in[i];
    a.out = (float*)d_out; a.ws = (unsigned char*)d_ws; a.ph_lo = 0; a.ph_hi = 1000;
    (void)hipMemsetAsync((char*)d_ws + OFF_BAR, 0, 16384, stream);
    void* args[] = {&a};
    hipError_t e = hipLaunchCooperativeKernel((const void*)mk_fwd, dim3(grid), dim3(512), args, LDS_BYTES, stream);
    if (e != hipSuccess) fprintf(stderr, "cooperative launch failed: %s (grid %d)\n", hipGetErrorString(e), grid);
}
```
